# Optimizing an MI355X kernel written in HIP

```python
import math
import jax, jax.numpy as jnp
from jax import lax
import numpy as np

D_MODEL = 1024
BATCH = 2
SEQ = 8192
DEPTH = 1

GRID_W = 64
CTX_LEN = 256
DN_HEADS = 8
DN_HEAD_DIM = 128
DN_DIM = DN_HEADS * DN_HEAD_DIM
DN_CONV = 5
CHUNK = 64
DT_MIN = 0.001
DT_MAX = 0.1
HY_DIM = 1024
HY_CONV = 3
HY_EMB = 33
HY_FILTER_WIDTH = 64
HY_DECAY_TARGET = 1e-2
HY_FAST_DECAY = 0.3
HY_SLOW_DECAY = 1.5
EPS = 1e-6

PROJ_NAMES = ('q', 'k', 'v', 'z_a', 'beta_f', 'beta_b', 'a_f', 'a_b',
              'hy_v', 'hy_x1', 'hy_x2', 'z_b', 'g_a', 'g_b')
PROJ_SIZES = (DN_DIM, DN_DIM, DN_DIM, DN_DIM, DN_HEADS, DN_HEADS, DN_HEADS, DN_HEADS,
              HY_DIM, HY_DIM, HY_DIM, HY_DIM, D_MODEL, D_MODEL)

kernel_name = 'hybrid_gdn_hyena_prefix_trunk'


def rmsnorm(x, g):
    x32 = x.astype(jnp.float32)
    y = x32 * lax.rsqrt(jnp.mean(x32 * x32, axis=-1, keepdims=True) + EPS)
    return (y * g.astype(jnp.float32)).astype(x.dtype)


def l2norm(t):
    return t * lax.rsqrt(jnp.sum(t * t, axis=-1, keepdims=True) + EPS)


def short_conv(u, w, rows, row_len):
    bsz, _, ch = u.shape
    k = w.shape[0]
    pad = k // 2
    r = jnp.pad(u.reshape(bsz, rows, row_len, ch), ((0, 0), (0, 0), (pad, pad), (0, 0)))
    out = r[:, :, 0:row_len] * w[0]
    for j in range(1, k):
        out = out + r[:, :, j:j + row_len] * w[j]
    return out.reshape(bsz, rows * row_len, ch)


def project(h, w_in):
    z = h @ w_in
    points = [int(s) for s in np.cumsum(PROJ_SIZES)[:-1]]
    return dict(zip(PROJ_NAMES, jnp.split(z, points, axis=-1)))


def chunk_gated_delta(q, k, v, g, beta, s0):
    bsz, seqlen, nh, _ = q.shape
    dv = v.shape[-1]
    n = seqlen // CHUNK

    def to_chunks(t):
        t = t.reshape((bsz, n, CHUNK, nh) + t.shape[3:])
        return jnp.moveaxis(t, (1, 3), (0, 2))

    qc, kc, vc, gc, bc = (to_chunks(t) for t in (q, k, v, g, beta))
    gc = jnp.cumsum(gc, axis=-1)
    idx = jnp.arange(CHUNK)
    incl = idx[:, None] >= idx[None, :]
    strict = idx[:, None] > idx[None, :]
    decay = jnp.exp(jnp.where(incl, gc[..., :, None] - gc[..., None, :], -jnp.inf))
    kb = kc * bc[..., None]
    lmat = jnp.where(strict, jnp.einsum('nbhid,nbhjd->nbhij', kb, kc) * decay, 0.0)
    a_sys = lmat + jnp.eye(CHUNK, dtype=lmat.dtype)
    rhs = jnp.concatenate([vc * bc[..., None], kb * jnp.exp(gc)[..., None]], axis=-1)
    sol = lax.linalg.triangular_solve(a_sys, rhs, left_side=True, lower=True, unit_diagonal=True)
    u, w = sol[..., :dv], sol[..., dv:]
    attn = jnp.einsum('nbhid,nbhjd->nbhij', qc, kc) * decay

    def step(s, inp):
        q_i, k_i, u_i, w_i, g_i, a_i = inp
        v_new = u_i - jnp.einsum('bhck,bhkv->bhcv', w_i, s)
        o_i = (jnp.einsum('bhck,bhkv->bhcv', q_i * jnp.exp(g_i)[..., None], s)
               + jnp.einsum('bhij,bhjv->bhiv', a_i, v_new))
        g_last = g_i[..., -1:]
        s = (s * jnp.exp(g_last)[..., None]
             + jnp.einsum('bhck,bhcv->bhkv', k_i * jnp.exp(g_last - g_i)[..., None], v_new))
        return s, o_i

    s_final, o = lax.scan(step, s0, (qc, kc, u, w, gc, attn))
    o = jnp.moveaxis(o, (0, 2), (1, 3)).reshape(bsz, seqlen, nh, dv)
    return o, s_final


def deltanet(p, lp, rows, row_len, states):
    f32 = jnp.float32
    bsz, seqlen, _ = p['q'].shape
    qkv = jax.nn.silu(short_conv(jnp.concatenate([p['q'], p['k'], p['v']], axis=-1),
                                 lp['dn_conv_w'], rows, row_len)).astype(f32)
    q, k, v = (t.reshape(bsz, seqlen, DN_HEADS, DN_HEAD_DIM) for t in jnp.split(qkv, 3, axis=-1))
    q = l2norm(q) * (DN_HEAD_DIM ** -0.5)
    k = l2norm(k)

    def gate_terms(a_raw, b_raw, d):
        g = -jnp.exp(lp['dn_a_log'][d].astype(f32)) * jax.nn.softplus(
            a_raw.astype(f32) + lp['dn_dt_bias'][d].astype(f32))
        return g, jax.nn.sigmoid(b_raw.astype(f32))

    g_f, beta_f = gate_terms(p['a_f'], p['beta_f'], 0)
    g_b, beta_b = gate_terms(p['a_b'], p['beta_b'], 1)
    flip = lambda t: jnp.flip(t, axis=1)
    o_f, s_f = chunk_gated_delta(q, k, v, g_f, beta_f, states[0])
    o_b, s_b = chunk_gated_delta(flip(q), flip(k), flip(v), flip(g_b), flip(beta_b), states[1])
    o = o_f + flip(o_b)
    o = o * lax.rsqrt(jnp.mean(o * o, axis=-1, keepdims=True) + EPS) * lp['dn_norm_g'].astype(f32)
    o = o.reshape(bsz, seqlen, DN_DIM) * jax.nn.silu(p['z_a'].astype(f32))
    return o, (s_f, s_b)


def hyena_filters(seqlen, lp):
    f32 = jnp.float32
    t = jnp.linspace(0.0, 1.0, seqlen, dtype=f32)[:, None]
    bands = (HY_EMB - 1) // 2
    wpos = (2.0 * math.pi / seqlen) * jnp.arange(seqlen, dtype=f32)[:, None]
    fb = jnp.linspace(1e-4, bands - 1, bands, dtype=f32)[None, :]
    pe = jnp.concatenate([t, jnp.cos(fb * wpos), -jnp.sin(fb * wpos)], axis=-1)
    freq = lp['hy_f_freq'].astype(f32)
    a = jnp.sin(freq * (pe @ lp['hy_f_w1'].astype(f32) + lp['hy_f_b1'].astype(f32)))
    a = jnp.sin(freq * (a @ lp['hy_f_w2'].astype(f32) + lp['hy_f_b2'].astype(f32)))
    a = jnp.sin(freq * (a @ lp['hy_f_w3'].astype(f32) + lp['hy_f_b3'].astype(f32)))
    h = (a @ lp['hy_f_wout'].astype(f32)).reshape(seqlen, 2, 2, HY_DIM)
    deltas = jnp.abs(jnp.linspace(math.log(HY_DECAY_TARGET) / HY_SLOW_DECAY,
                                  math.log(HY_DECAY_TARGET) / HY_FAST_DECAY, HY_DIM, dtype=f32))
    h = h * jnp.exp(-t * deltas)[:, None, None, :]
    full = jnp.concatenate([h[:, 0], jnp.zeros((1, 2, HY_DIM), f32), h[:0:-1, 1]], axis=0)
    full = full * lax.rsqrt(jnp.sum(full * full, axis=0, keepdims=True) + EPS)
    return jnp.fft.rfft(full, axis=0)


def long_conv(u, hf, bias):
    seqlen = u.shape[1]
    uf = jnp.fft.rfft(u, n=2 * seqlen, axis=1)
    y = jnp.fft.irfft(uf * hf[None], n=2 * seqlen, axis=1)[:, :seqlen]
    return y + u * bias


def hyena(p, lp, rows, row_len):
    f32 = jnp.float32
    seqlen = p['hy_v'].shape[1]
    u = short_conv(jnp.concatenate([p['hy_v'], p['hy_x1'], p['hy_x2']], axis=-1),
                   lp['hy_conv_w'], rows, row_len) + lp['hy_conv_b']
    v, x1, x2 = jnp.split(u.astype(f32), 3, axis=-1)
    hf = hyena_filters(seqlen, lp)
    bias = lp['hy_bias'].astype(f32)
    z = x1 * long_conv(v, hf[:, 0], bias[0])
    z = x2 * long_conv(z, hf[:, 1], bias[1])
    return z * jax.nn.silu(p['z_b'].astype(f32))


def merge(p, o_a, o_b, lp):
    dt = p['g_a'].dtype
    y_a = o_a.astype(dt) @ lp['w_pa']
    y_b = o_b.astype(dt) @ lp['w_pb']
    m = jax.nn.sigmoid(p['g_a']) * y_a + jax.nn.sigmoid(p['g_b']) * y_b
    return m @ lp['w_out']


def setup_inputs(seed: int = 0) -> dict:
    key = jax.random.key(seed)
    ks = jax.random.split(key, 32)
    f32 = jnp.float32
    F = HY_FILTER_WIDTH

    def nrm(k, shape, scale):
        return jax.random.normal(k, shape, f32) * scale

    n_in = sum(PROJ_SIZES)
    dt = jnp.exp(jax.random.uniform(ks[8], (DEPTH, 2, DN_HEADS), f32, math.log(DT_MIN), math.log(DT_MAX)))
    return {
        'x': nrm(ks[0], (BATCH, SEQ, D_MODEL), 1.0),
        'c': nrm(ks[1], (BATCH, D_MODEL), 1.0),
        'ctx': nrm(ks[2], (BATCH, CTX_LEN, D_MODEL), 1.0),
        'c_ctx': nrm(ks[3], (D_MODEL,), 1.0),
        'w_mod': nrm(ks[4], (DEPTH, D_MODEL, 3 * D_MODEL), D_MODEL ** -0.5),
        'b_mod': nrm(ks[5], (DEPTH, 3 * D_MODEL), 0.02),
        'norm_g': 1.0 + nrm(ks[6], (DEPTH, D_MODEL), 0.02),
        'w_in': nrm(ks[7], (DEPTH, D_MODEL, n_in), D_MODEL ** -0.5),
        'dn_conv_w': nrm(ks[9], (DEPTH, DN_CONV, 3 * DN_DIM), DN_CONV ** -0.5),
        'dn_a_log': jnp.log(jax.random.uniform(ks[10], (DEPTH, 2, DN_HEADS), f32, 1.0, 16.0)),
        'dn_dt_bias': dt + jnp.log(-jnp.expm1(-dt)),
        'dn_norm_g': 1.0 + nrm(ks[11], (DEPTH, DN_HEAD_DIM), 0.02),
        'hy_conv_w': nrm(ks[12], (DEPTH, HY_CONV, 3 * HY_DIM), HY_CONV ** -0.5),
        'hy_conv_b': nrm(ks[13], (DEPTH, 3 * HY_DIM), 0.02),
        'hy_f_w1': nrm(ks[14], (DEPTH, HY_EMB, F), HY_EMB ** -0.5),
        'hy_f_b1': nrm(ks[15], (DEPTH, F), 0.02),
        'hy_f_w2': nrm(ks[16], (DEPTH, F, F), F ** -0.5),
        'hy_f_b2': nrm(ks[17], (DEPTH, F), 0.02),
        'hy_f_w3': nrm(ks[18], (DEPTH, F, F), F ** -0.5),
        'hy_f_b3': nrm(ks[19], (DEPTH, F), 0.02),
        'hy_f_wout': nrm(ks[20], (DEPTH, F, 4 * HY_DIM), F ** -0.5),
        'hy_f_freq': 1.0 + nrm(ks[21], (DEPTH, F), 0.02),
        'hy_bias': nrm(ks[22], (DEPTH, 2, HY_DIM), 1.0),
        'w_pa': nrm(ks[23], (DEPTH, DN_DIM, D_MODEL), DN_DIM ** -0.5),
        'w_pb': nrm(ks[24], (DEPTH, HY_DIM, D_MODEL), HY_DIM ** -0.5),
        'w_out': nrm(ks[25], (DEPTH, D_MODEL, D_MODEL), D_MODEL ** -0.5),
        'final_g': 1.0 + nrm(ks[26], (D_MODEL,), 0.02),
    }


def reference(x, c, ctx, c_ctx, w_mod, b_mod, norm_g, w_in, dn_conv_w, dn_a_log, dn_dt_bias, dn_norm_g,
              hy_conv_w, hy_conv_b, hy_f_w1, hy_f_b1, hy_f_w2, hy_f_b2, hy_f_w3, hy_f_b3, hy_f_wout,
              hy_f_freq, hy_bias, w_pa, w_pb, w_out, final_g):
    bsz, n_lat, _ = x.shape
    rows = n_lat // GRID_W
    zero = jnp.zeros((bsz, DN_HEADS, DN_HEAD_DIM, DN_HEAD_DIM), jnp.float32)
    ctx_s = ctx
    for i in range(DEPTH):
        lp = {'dn_conv_w': dn_conv_w[i], 'dn_a_log': dn_a_log[i], 'dn_dt_bias': dn_dt_bias[i],
              'dn_norm_g': dn_norm_g[i], 'hy_conv_w': hy_conv_w[i], 'hy_conv_b': hy_conv_b[i],
              'hy_f_w1': hy_f_w1[i], 'hy_f_b1': hy_f_b1[i], 'hy_f_w2': hy_f_w2[i], 'hy_f_b2': hy_f_b2[i],
              'hy_f_w3': hy_f_w3[i], 'hy_f_b3': hy_f_b3[i], 'hy_f_wout': hy_f_wout[i],
              'hy_f_freq': hy_f_freq[i], 'hy_bias': hy_bias[i], 'w_pa': w_pa[i], 'w_pb': w_pb[i],
              'w_out': w_out[i]}
        mod_x = jax.nn.silu(c) @ w_mod[i] + b_mod[i]
        mod_c = jax.nn.silu(c_ctx) @ w_mod[i] + b_mod[i]
        sh_x, sc_x, gt_x = jnp.split(mod_x[:, None, :], 3, axis=-1)
        sh_c, sc_c, gt_c = jnp.split(mod_c[None, None, :], 3, axis=-1)
        hc = rmsnorm(ctx_s, norm_g[i]) * (1.0 + sc_c) + sh_c
        pc = project(hc, w_in[i])
        oc, ctx_states = deltanet(pc, lp, 1, CTX_LEN, (zero, zero))
        hx = rmsnorm(x, norm_g[i]) * (1.0 + sc_x) + sh_x
        px = project(hx, w_in[i])
        ox, _ = deltanet(px, lp, rows, GRID_W, ctx_states)
        yx = hyena(px, lp, rows, GRID_W)
        x = x + gt_x * merge(px, ox, yx, lp)
        if i < DEPTH - 1:
            yc = hyena(pc, lp, 1, CTX_LEN)
            ctx_s = ctx_s + gt_c * merge(pc, oc, yc, lp)
    return rmsnorm(x, final_g)
```

```cpp
#include <hip/hip_runtime.h>
#include <hip/hip_bf16.h>
#include <hip/hip_cooperative_groups.h>
#include <cstdio>
namespace cg = cooperative_groups;

typedef unsigned short u16;
using bf16x8 = __attribute__((ext_vector_type(8))) short;
using f32x4 = __attribute__((ext_vector_type(4))) float;
typedef unsigned u32x4 __attribute__((ext_vector_type(4)));

#define NTH 512
#ifndef REP_A
#define REP_A 1
#endif
#ifndef REP_B
#define REP_B 0x101
#endif
#define EPSV 1e-6f
constexpr int LDS_BYTES = 131072 + 8192;

constexpr size_t SZ_WTIN = (size_t)10496 * 1024 * 2;
constexpr size_t SZ_HBUF = (size_t)16896 * 1024 * 2;
constexpr size_t OFF_WTIN = 0;
constexpr size_t OFF_HBUF = OFF_WTIN + SZ_WTIN;
constexpr size_t OFF_WTPA = OFF_HBUF + SZ_HBUF;
constexpr size_t OFF_WTPB = OFF_WTPA + 2097152;
constexpr size_t OFF_WTOUT= OFF_WTPB + 2097152;
constexpr size_t OFF_MOD  = OFF_WTOUT + 2097152;
constexpr size_t OFF_A3   = OFF_MOD + 36864;
constexpr size_t OFF_TW   = OFF_A3 + 2097152;
constexpr size_t OFF_GATES= OFF_TW + 131072;
constexpr size_t OFF_BAR  = OFF_GATES + (size_t)16896*32*4;
constexpr size_t OFF_R1C  = OFF_BAR + 16384;
constexpr size_t OFF_BIG  = OFF_R1C + (size_t)64*49152;
constexpr size_t TA_STRIDE= 25600;
constexpr size_t SZ_TA    = (size_t)16*132*TA_STRIDE;
constexpr size_t OFF_R1   = OFF_BIG;
constexpr size_t OFF_TAB  = OFF_R1 + (size_t)16896*3072*2;
constexpr size_t OFF_ZA   = OFF_TAB + SZ_TA;
constexpr size_t OFF_OA   = OFF_ZA;
constexpr size_t OFF_PHYT = OFF_BIG;
constexpr size_t OFF_YBT  = OFF_BIG + (size_t)2048*16384*2;
constexpr size_t OFF_YB   = OFF_BIG;
constexpr size_t OFF_FS   = OFF_YBT + (size_t)16384*1024*2;
constexpr size_t OFF_MA   = OFF_BIG + (size_t)16384*1024*2;
constexpr size_t OFF_M    = OFF_FS;
constexpr size_t WS_NEED  = OFF_ZA + (size_t)16384*1024*2;
static_assert(OFF_FS + (size_t)256*24576*8 <= OFF_ZA, "scratch overlaps oa");

struct Params {
  const float *x,*c,*ctx,*c_ctx,*w_mod,*b_mod,*norm_g,*w_in,*dn_conv_w,*dn_a_log,*dn_dt_bias,*dn_norm_g,
    *hy_conv_w,*hy_conv_b,*f_w1,*f_b1,*f_w2,*f_b2,*f_w3,*f_b3,*f_wout,*f_freq,*hy_bias,*w_pa,*w_pb,*w_out,*final_g;
  float* out;
  char* ws;
  int rep_a, rep_b;
};

extern __shared__ __attribute__((aligned(16))) char smem[];
typedef const __attribute__((address_space(4))) unsigned long long* KP;
__device__ __forceinline__ Params load_params(KP k){
  Params p; unsigned long long* d=(unsigned long long*)&p;
  _Pragma("unroll") for (int i=0;i<(int)(sizeof(Params)/8);++i) d[i]=k[i];
  return p; }

typedef float f32x2_t __attribute__((ext_vector_type(2)));
typedef __bf16 bf16x2_t __attribute__((ext_vector_type(2)));
__device__ __forceinline__ u16 f2bf(float f){ __bf16 h=(__bf16)f; return __builtin_bit_cast(u16,h); }
__device__ __forceinline__ float bf2f(u16 h){ return __uint_as_float(((unsigned)h)<<16); }
__device__ __forceinline__ unsigned pack2(float a, float b){ f32x2_t v={a,b}; bf16x2_t r=__builtin_convertvector(v,bf16x2_t); return __builtin_bit_cast(unsigned,r); }
__device__ __forceinline__ float siluf(float x){ return x/(1.f+__expf(-x)); }
__device__ __forceinline__ float sigmf(float x){ return 1.f/(1.f+__expf(-x)); }
__device__ __forceinline__ float wave_sum(float v){
  for (int o=32;o>=1;o>>=1) v += __shfl_xor(v,o);
  return v;
}

#define HD __device__ __forceinline__
HD float2 cmul(float2 a, float2 b){ return make_float2(a.x*b.x - a.y*b.y, a.x*b.y + a.y*b.x); }
HD float2 cmulc(float2 a, float2 b){ return make_float2(a.x*b.x + a.y*b.y, a.y*b.x - a.x*b.y); }
template<bool INV, bool NOTW>
HD void bf4c(float2* Z, int i0, int i1, int i2, int i3, float2 w1, float2 w2, float2 w3){
  float2 a0=Z[i0], a1=Z[i1], a2=Z[i2], a3=Z[i3];
  if (INV && !NOTW){ a1=cmulc(a1,w1); a2=cmulc(a2,w2); a3=cmulc(a3,w3); }
  float2 s02=make_float2(a0.x+a2.x,a0.y+a2.y), d02=make_float2(a0.x-a2.x,a0.y-a2.y);
  float2 s13=make_float2(a1.x+a3.x,a1.y+a3.y), d13=make_float2(a1.x-a3.x,a1.y-a3.y);
  float2 y0=make_float2(s02.x+s13.x,s02.y+s13.y), y2=make_float2(s02.x-s13.x,s02.y-s13.y);
  float2 ym=make_float2(d02.x+d13.y,d02.y-d13.x);
  float2 yp=make_float2(d02.x-d13.y,d02.y+d13.x);
  float2 y1, y3;
  if (INV){ y1=yp; y3=ym; } else if (NOTW){ y1=ym; y3=yp; } else { y1=cmul(ym,w1); y2=cmul(y2,w2); y3=cmul(yp,w3); }
  Z[i0]=y0; Z[i1]=y1; Z[i2]=y2; Z[i3]=y3;
}
HD int rev4_14(int p){ unsigned r = __brev((unsigned)p) >> 18; return (int)(((r & 0x2AAAu) >> 1) | ((r & 0x1555u) << 1)); }
template<bool INV, int LQ, bool BARRIER=true>
HD void fft_pass(float2* Z, const float2* twA, const float2* twB, int tid){
  constexpr int q=1<<LQ; constexpr int tws=4096>>LQ;
  if (LQ==12){
    _Pragma("unroll 2") for (int i=0;i<8;++i){ int t=tid+512*i; int k=t;
      float2 w1=cmul(twA[k>>6],twB[k&63]), w2=cmul(w1,w1), w3=cmul(w2,w1);
      bf4c<INV,false>(Z,t,t+q,t+2*q,t+3*q,w1,w2,w3); }
  } else if (LQ==10){
    _Pragma("unroll") for (int e=0;e<2;++e){ int j=tid+512*e; int k=j*tws;
      float2 w1=cmul(twA[k>>6],twB[k&63]), w2=cmul(w1,w1), w3=cmul(w2,w1);
      _Pragma("unroll") for (int ip=0;ip<4;++ip){ int base=ip*4096+j; bf4c<INV,false>(Z,base,base+q,base+2*q,base+3*q,w1,w2,w3); } }
  } else {
    int j=tid&(q-1); int base0=((tid>>LQ)<<(LQ+2))+j;
    float2 w1=make_float2(1.f,0.f), w2=w1, w3=w1;
    if (LQ>0){ int k=j*tws; w1=cmul(twA[k>>6],twB[k&63]); w2=cmul(w1,w1); w3=cmul(w2,w1); }
    _Pragma("unroll") for (int i=0;i<8;++i){ int base=base0+i*2048; bf4c<INV,(LQ==0)>(Z,base,base+q,base+2*q,base+3*q,w1,w2,w3); }
  }
  if (BARRIER) __syncthreads(); else asm volatile("s_waitcnt lgkmcnt(0)" ::: "memory");
}
__device__ __forceinline__ void fft_fwd_head(float2* Z, const float2* twA, const float2* twB, int tid){
  fft_pass<false,10>(Z,twA,twB,tid); fft_pass<false,8>(Z,twA,twB,tid); fft_pass<false,6,false>(Z,twA,twB,tid);
  fft_pass<false,4,false>(Z,twA,twB,tid); fft_pass<false,2,false>(Z,twA,twB,tid);
}
__device__ __forceinline__ void fft_inv_tail(float2* Z, const float2* twA, const float2* twB, int tid){
  fft_pass<true,2,false>(Z,twA,twB,tid); fft_pass<true,4,false>(Z,twA,twB,tid); fft_pass<true,6>(Z,twA,twB,tid);
  fft_pass<true,8>(Z,twA,twB,tid); fft_pass<true,10>(Z,twA,twB,tid);
}
HD void fwd12_padded(float2* Z, const float2* twA, const float2* twB, int t, float2 a0, float2 a1){
  float2 w1=cmul(twA[t>>6],twB[t&63]), w2=cmul(w1,w1), w3=cmul(w2,w1);
  Z[t]=make_float2(a0.x+a1.x,a0.y+a1.y);
  Z[t+4096]=cmul(make_float2(a0.x+a1.y,a0.y-a1.x),w1);
  Z[t+8192]=cmul(make_float2(a0.x-a1.x,a0.y-a1.y),w2);
  Z[t+12288]=cmul(make_float2(a0.x-a1.y,a0.y+a1.x),w3);
}
HD void inv12_half(const float2* Z, const float2* twA, const float2* twB, int t, float2& x0, float2& x1){
  float2 w1=cmul(twA[t>>6],twB[t&63]), w2=cmul(w1,w1), w3=cmul(w2,w1);
  float2 b0=Z[t], b1=cmulc(Z[t+4096],w1), b2=cmulc(Z[t+8192],w2), b3=cmulc(Z[t+12288],w3);
  float2 s02=make_float2(b0.x+b2.x,b0.y+b2.y), d02=make_float2(b0.x-b2.x,b0.y-b2.y);
  float2 s13=make_float2(b1.x+b3.x,b1.y+b3.y), d13=make_float2(b1.x-b3.x,b1.y-b3.y);
  x0=make_float2(s02.x+s13.x,s02.y+s13.y);
  x1=make_float2(d02.x-d13.y,d02.y+d13.x);
}
typedef _Float16 f16x2 __attribute__((ext_vector_type(2)));
__device__ __forceinline__ void fft_mid(float2* Z, const f16x2* Hp, int tid){
  _Pragma("unroll 4") for (int i=0;i<8;++i){ int base=(tid<<2)+i*2048;
    u32x4 hw=*(const u32x4*)(Hp+base);
    unsigned hw0=hw[0], hw1=hw[1], hw2=hw[2], hw3=hw[3];
    float2 a0=Z[base], a1=Z[base+1], a2=Z[base+2], a3=Z[base+3];
    float2 s02=make_float2(a0.x+a2.x,a0.y+a2.y), d02=make_float2(a0.x-a2.x,a0.y-a2.y);
    float2 s13=make_float2(a1.x+a3.x,a1.y+a3.y), d13=make_float2(a1.x-a3.x,a1.y-a3.y);
    float2 y0=make_float2(s02.x+s13.x,s02.y+s13.y), y2=make_float2(s02.x-s13.x,s02.y-s13.y);
    float2 y1=make_float2(d02.x+d13.y,d02.y-d13.x);
    float2 y3=make_float2(d02.x-d13.y,d02.y+d13.x);
    f16x2 h0=__builtin_bit_cast(f16x2,hw0), h1=__builtin_bit_cast(f16x2,hw1), h2=__builtin_bit_cast(f16x2,hw2), h3=__builtin_bit_cast(f16x2,hw3);
    float2 b0=cmul(y0,make_float2((float)h0[0],(float)h0[1])), b1=cmul(y1,make_float2((float)h1[0],(float)h1[1]));
    float2 b2=cmul(y2,make_float2((float)h2[0],(float)h2[1])), b3=cmul(y3,make_float2((float)h3[0],(float)h3[1]));
    float2 t02=make_float2(b0.x+b2.x,b0.y+b2.y), e02=make_float2(b0.x-b2.x,b0.y-b2.y);
    float2 t13=make_float2(b1.x+b3.x,b1.y+b3.y), e13=make_float2(b1.x-b3.x,b1.y-b3.y);
    Z[base]=make_float2(t02.x+t13.x,t02.y+t13.y); Z[base+2]=make_float2(t02.x-t13.x,t02.y-t13.y);
    Z[base+1]=make_float2(e02.x-e13.y,e02.y+e13.x);
    Z[base+3]=make_float2(e02.x+e13.y,e02.y-e13.x);
  }
  asm volatile("s_waitcnt lgkmcnt(0)" ::: "memory");
}

constexpr int BM=256, BK=64, HALF=128, HT=HALF*BK;
__device__ __forceinline__ int lds_byte(int r, int c) {
  int st=(r>>4)*2+(c>>5), rr=r&15, cc=c&31, ob=rr*64+cc*2;
  return st*1024 + (ob ^ (((ob>>9)&1)<<5));
}
__device__ __forceinline__ void stage_rc(int b, int&R, int&C) {
  int st=b/1024, sb=b%1024, swz=sb^(((sb>>9)&1)<<5);
  R=(st>>1)*16+swz/64; C=(st&1)*32+(swz%64)/2;
}
#define GK 1024
#define SA(b,h) (shm+((b)*2+(h))*HT)
#define SB(b,h) (shm+(4+(b)*2+(h))*HT)
#define STAGE(P,BASE,br,kt) do{const u16* _gb=(BASE)+((long)(br)*GK+(long)(kt)*BK); \
    __builtin_amdgcn_global_load_lds((const unsigned*)(_gb+soff0), \
      (__attribute__((address_space(3))) unsigned*)((__attribute__((address_space(3))) char*)(P)+gtid*16),16,0,0); \
    __builtin_amdgcn_global_load_lds((const unsigned*)(_gb+soff1), \
      (__attribute__((address_space(3))) unsigned*)((__attribute__((address_space(3))) char*)(P)+gtid*16+8192),16,0,0);}while(0)
#define LDA(dst,b,h) _Pragma("unroll") for(int m=0;m<4;++m) _Pragma("unroll") for(int k=0;k<2;++k) \
  dst[m][k]=*reinterpret_cast<const __attribute__((address_space(3))) bf16x8*>((__attribute__((address_space(3))) char*)SA(b,h)+lds_byte(wr*64+m*16+fr,k*32+fq*8))
#define LDB(dst,b,h) _Pragma("unroll") for(int n=0;n<2;++n) _Pragma("unroll") for(int k=0;k<2;++k) \
  dst[n][k]=*reinterpret_cast<const __attribute__((address_space(3))) bf16x8*>((__attribute__((address_space(3))) char*)SB(b,h)+lds_byte(wc*32+n*16+fr,k*32+fq*8))
#define MMA(ai,bj,At,Bt_) do{__builtin_amdgcn_s_setprio(1); \
  _Pragma("unroll") for(int m=0;m<4;++m) _Pragma("unroll") for(int n=0;n<2;++n) _Pragma("unroll") for(int k=0;k<2;++k) \
    acc[ai][bj][m][n]=__builtin_amdgcn_mfma_f32_16x16x32_bf16(At[m][k],Bt_[n][k],acc[ai][bj][m][n],0,0,0); \
  __builtin_amdgcn_s_setprio(0);}while(0)
#define WAIT_V(n) asm volatile("s_waitcnt vmcnt(" #n ")":::"memory")
#define WAIT_L(n) asm volatile("s_waitcnt lgkmcnt(" #n ")":::"memory")
#define BAR __builtin_amdgcn_s_barrier()
#define SCHED __builtin_amdgcn_sched_barrier(0)

__device__ __forceinline__ void gemm_core(const u16* __restrict__ A, const u16* __restrict__ Bt, int brow, int bcol,
                                          f32x4 (&acc)[2][2][4][2]) {
  __attribute__((address_space(3))) u16* shm = (__attribute__((address_space(3))) u16*)smem;
  int gtid=threadIdx.x; asm volatile("" : "+v"(gtid));
  int wid=gtid>>6,lane=gtid&63,wr=wid>>2,wc=wid&3,fr=lane&15,fq=lane>>4;
  _Pragma("unroll") for(int a=0;a<2;++a) _Pragma("unroll") for(int b=0;b<2;++b) _Pragma("unroll") for(int m=0;m<4;++m) _Pragma("unroll") for(int n=0;n<2;++n) acc[a][b][m][n]=f32x4{0.f,0.f,0.f,0.f};
  bf16x8 At[4][2],B0[2][2],B1[2][2];
  int soff0, soff1; { int _r,_c; stage_rc(gtid*16,_r,_c); soff0=_r*GK+_c; stage_rc(gtid*16+8192,_r,_c); soff1=_r*GK+_c; }
  constexpr int nt=GK/BK;
  STAGE(SB(0,0),Bt,bcol,0); STAGE(SA(0,0),A,brow,0);
  STAGE(SB(0,1),Bt,bcol+HALF,0); STAGE(SA(0,1),A,brow+HALF,0);
  if(wr==1)BAR;
  WAIT_V(4); BAR;
  STAGE(SB(1,0),Bt,bcol,1); STAGE(SA(1,0),A,brow,1); STAGE(SB(1,1),Bt,bcol+HALF,1);
  WAIT_V(6); BAR;
  for(int t=0;t<nt-2;t+=2){
    LDB(B0,0,0); SCHED; LDA(At,0,0); STAGE(SA(1,1),A,brow+HALF,t+1);
    WAIT_L(8); BAR; WAIT_L(0); MMA(0,0,At,B0); BAR; SCHED;
    LDB(B1,0,1); STAGE(SB(0,0),Bt,bcol,t+2);
    BAR; WAIT_L(0); MMA(0,1,At,B1); BAR;
    LDA(At,0,1); STAGE(SA(0,0),A,brow,t+2);
    BAR; WAIT_L(0); MMA(1,0,At,B0); BAR; SCHED;
    STAGE(SB(0,1),Bt,bcol+HALF,t+2);
    WAIT_V(6); BAR; MMA(1,1,At,B1); BAR;
    LDB(B0,1,0); SCHED; LDA(At,1,0); STAGE(SA(0,1),A,brow+HALF,t+2);
    WAIT_L(8); BAR; WAIT_L(0); MMA(0,0,At,B0); BAR; SCHED;
    LDB(B1,1,1); STAGE(SB(1,0),Bt,bcol,t+3);
    BAR; WAIT_L(0); MMA(0,1,At,B1); BAR;
    LDA(At,1,1); STAGE(SA(1,0),A,brow,t+3);
    BAR; WAIT_L(0); MMA(1,0,At,B0); BAR; SCHED;
    STAGE(SB(1,1),Bt,bcol+HALF,t+3);
    WAIT_V(6); BAR; MMA(1,1,At,B1); BAR;
  }
  { LDB(B0,0,0); LDA(At,0,0); STAGE(SA(1,1),A,brow+HALF,nt-1);
    BAR; WAIT_L(0); MMA(0,0,At,B0); BAR;
    LDB(B1,0,1); BAR; WAIT_L(0); MMA(0,1,At,B1); BAR;
    LDA(At,0,1); WAIT_V(4); BAR; WAIT_L(0); MMA(1,0,At,B0); MMA(1,1,At,B1); BAR; }
  { LDB(B0,1,0); LDA(At,1,0); WAIT_V(2); BAR; WAIT_L(0); MMA(0,0,At,B0); BAR;
    LDB(B1,1,1); WAIT_V(0); BAR; WAIT_L(0); MMA(0,1,At,B1); BAR;
    LDA(At,1,1); BAR; WAIT_L(0); MMA(1,0,At,B0); MMA(1,1,At,B1); BAR; }
  if(wr==0)BAR;
  SCHED;
}
#define EPI_BEGIN { int _t=threadIdx.x; asm volatile("" : "+v"(_t)); int _wid=_t>>6,_lane=_t&63,_wr=_wid>>2,_wc=_wid&3,_fr=_lane&15,_fq=_lane>>4; \
  _Pragma("unroll") for(int ai=0;ai<2;++ai) _Pragma("unroll") for(int bj=0;bj<2;++bj) _Pragma("unroll") for(int m=0;m<4;++m) _Pragma("unroll") for(int n=0;n<2;++n){ \
    int R0=ai*HALF+_wr*64+m*16+_fq*4, C0=bj*HALF+_wc*32+n*16+_fr; f32x4 v=acc[ai][bj][m][n]; (void)R0; (void)C0;
#define EPI_END asm volatile("":::"memory"); }}
#define EPIG_BEGIN { int _t=threadIdx.x; asm volatile("" : "+v"(_t)); int _wid=_t>>6,_lane=_t&63,_wr=_wid>>2,_wc=_wid&3,_fr=_lane&15,_fq=_lane>>4; \
  _Pragma("unroll") for(int ai=0;ai<2;++ai) _Pragma("unroll") for(int bj=0;bj<2;++bj){
#define EPIG_FOR _Pragma("unroll") for(int m=0;m<4;++m) _Pragma("unroll") for(int n=0;n<2;++n){ const int idx=m*2+n; int R0=ai*HALF+_wr*64+m*16+_fq*4, C0=bj*HALF+_wc*32+n*16+_fr; (void)idx; (void)R0; (void)C0;
#define EPIG_ENDFOR }
#define EPIG_END asm volatile("":::"memory"); }}

__device__ __forceinline__ int wperm(int np){ return np<4096 ? np : (np<10240 ? np+32 : (np<10272 ? 4096+(np-10240) : -1)); }
__device__ __forceinline__ void transpose_tile(const float* __restrict__ src, int ld_src, int kind, u16* __restrict__ dst, int n0, int k0, int tid){
  float* tile = (float*)smem;
  _Pragma("unroll") for (int i=0;i<2;++i){ int e=tid+512*i; int kk=e>>4, n4=(e&15)*4; int np=n0+n4;
    float4 v=make_float4(0.f,0.f,0.f,0.f);
    if (kind==0){ int ns=wperm(np);
      if (ns>=0) v=*(const float4*)(src+(size_t)(k0+kk)*ld_src+ns); }
    else v=*(const float4*)(src+(size_t)(k0+kk)*ld_src+np);
    *(float4*)(tile+kk*68+n4)=v; }
  __syncthreads();
  { int nn=tid>>3, k8=(tid&7)*8;
    u32x4 pk;
    pk[0]=pack2(tile[(k8+0)*68+nn],tile[(k8+1)*68+nn]); pk[1]=pack2(tile[(k8+2)*68+nn],tile[(k8+3)*68+nn]);
    pk[2]=pack2(tile[(k8+4)*68+nn],tile[(k8+5)*68+nn]); pk[3]=pack2(tile[(k8+6)*68+nn],tile[(k8+7)*68+nn]);
    *(u32x4*)(dst+(size_t)(n0+nn)*1024+k0+k8)=pk; }
  __syncthreads();
}

__device__ __forceinline__ void phase_prep(KP kp_){ asm volatile("" : "+s"(kp_)); const Params p=load_params(kp_);
  int ftid=threadIdx.x; asm volatile("" : "+v"(ftid));
  int tid=ftid, lane=tid&63, wid=tid>>6;
  char* ws=p.ws;
  for (int it=blockIdx.x; it<2624; it+=gridDim.x){
    { int nt_=it>>4, kt=it&15; transpose_tile(p.w_in,10272,0,(u16*)(ws+OFF_WTIN),nt_*64,kt*64,tid); }
    if (false) { int j=it-2624; int w=j>>8; int r=j&255; int nt_=r>>4, kt=r&15;
      const float* src = w==0?p.w_pa:(w==1?p.w_pb:p.w_out); size_t off = w==0?OFF_WTPA:(w==1?OFF_WTPB:OFF_WTOUT);
      transpose_tile(src,1024,1,(u16*)(ws+off),nt_*64,kt*64,tid); }
  }
  float* modv=(float*)(ws+OFF_MOD);
  for (int it=blockIdx.x; it<256; it+=gridDim.x){
    float acc[3][12];
    for(int a=0;a<3;++a)for(int j=0;j<12;++j)acc[a][j]=0.f;
    for (int r=0;r<2;++r){ int k=tid+512*r;
      float s0=siluf(p.c[k]), s1=siluf(p.c[1024+k]), s2=siluf(p.c_ctx[k]);
      const float4* wp=(const float4*)(p.w_mod+(size_t)k*3072+it*12);
      for(int q=0;q<3;++q){ float4 w=wp[q];
        acc[0][q*4+0]+=s0*w.x; acc[0][q*4+1]+=s0*w.y; acc[0][q*4+2]+=s0*w.z; acc[0][q*4+3]+=s0*w.w;
        acc[1][q*4+0]+=s1*w.x; acc[1][q*4+1]+=s1*w.y; acc[1][q*4+2]+=s1*w.z; acc[1][q*4+3]+=s1*w.w;
        acc[2][q*4+0]+=s2*w.x; acc[2][q*4+1]+=s2*w.y; acc[2][q*4+2]+=s2*w.z; acc[2][q*4+3]+=s2*w.w; } }
    float* red=(float*)smem;
    for(int a=0;a<3;++a)for(int j=0;j<12;++j){ float v=wave_sum(acc[a][j]); if(lane==0) red[wid*36+a*12+j]=v; }
    __syncthreads();
    if (tid<36){ float s=0; for(int w=0;w<8;++w)s+=red[w*36+tid]; int a=tid/12,j=tid%12; modv[a*3072+it*12+j]=s+p.b_mod[it*12+j]; }
    __syncthreads();
  }
}
__device__ __forceinline__ void phase_side(KP kp_, int bid, int nb){ asm volatile("" : "+s"(kp_)); const Params p=load_params(kp_);
  int ftid=threadIdx.x; asm volatile("" : "+v"(ftid));
  int tid=ftid, lane=tid&63, wid=tid>>6;
  char* ws=p.ws;
  for (int j=bid; j<768; j+=nb){ int w=j>>8; int r=j&255; int nt_=r>>4, kt=r&15;
    const float* src = w==0?p.w_pa:(w==1?p.w_pb:p.w_out); size_t off = w==0?OFF_WTPA:(w==1?OFF_WTPB:OFF_WTOUT);
    transpose_tile(src,1024,1,(u16*)(ws+off),nt_*64,kt*64,tid); }
  _Float16* a3=(_Float16*)(ws+OFF_A3);
  for (int t=bid*8+wid; t<8192; t+=nb*8){
    float pe=0.f;
    if (lane==0) pe=(float)t/8191.f;
    else if (lane<33){ int bi=(lane-1)&15; float s=(float)bi/15.f; float fb=1e-4f*(1.f-s)+15.f*s; float wpos=(float)(6.283185307179586/8192.0)*(float)t; float arg=fb*wpos;
      pe = lane<17 ? cosf(arg) : -sinf(arg); }
    float fr_=p.f_freq[lane];
    float acc=p.f_b1[lane];
    for(int i=0;i<33;++i) acc += __shfl(pe,i)*p.f_w1[i*64+lane];
    float a1=sinf(fr_*acc);
    acc=p.f_b2[lane];
    for(int i=0;i<64;++i) acc += __shfl(a1,i)*p.f_w2[i*64+lane];
    float a2=sinf(fr_*acc);
    acc=p.f_b3[lane];
    for(int i=0;i<64;++i) acc += __shfl(a2,i)*p.f_w3[i*64+lane];
    a3[t*64+lane]=(_Float16)sinf(fr_*acc);
  }
  float2* tw=(float2*)(ws+OFF_TW);
  for (int k=bid*512+tid; k<16384; k+=nb*512){
    float s,c; sincospif((float)k/8192.f,&s,&c); tw[k]=make_float2(c,-s); }
}

__device__ __forceinline__ void phase_h(KP kp_){ asm volatile("" : "+s"(kp_)); const Params p=load_params(kp_);
  int ftid=threadIdx.x; asm volatile("" : "+v"(ftid));
  int lane=ftid&63, wid=ftid>>6;
  const float* modv=(const float*)(p.ws+OFF_MOD);
  u16* hbuf=(u16*)(p.ws+OFF_HBUF);
  _Pragma("unroll 2") for (int r=blockIdx.x*8+wid; r<16896; r+=gridDim.x*8){
    const float* src = r<16384 ? p.x+(size_t)r*1024 : p.ctx+(size_t)(r-16384)*1024;
    int v = r<16384 ? (r>>13) : 2;
    float4 xv[4]; float ss=0.f;
    for(int i=0;i<4;++i){ xv[i]=*(const float4*)(src+lane*4+256*i); ss+=xv[i].x*xv[i].x+xv[i].y*xv[i].y+xv[i].z*xv[i].z+xv[i].w*xv[i].w; }
    ss=wave_sum(ss); float rstd=rsqrtf(ss*(1.f/1024.f)+EPSV);
    for(int i=0;i<4;++i){ int col=lane*4+256*i;
      float4 g=*(const float4*)(p.norm_g+col); float4 sh=*(const float4*)(modv+v*3072+col); float4 sc=*(const float4*)(modv+v*3072+1024+col);
      float h0=xv[i].x*rstd*g.x*(1.f+sc.x)+sh.x, h1=xv[i].y*rstd*g.y*(1.f+sc.y)+sh.y, h2=xv[i].z*rstd*g.z*(1.f+sc.z)+sh.z, h3=xv[i].w*rstd*g.w*(1.f+sc.w)+sh.w;
      uint2 pk; pk.x=pack2(h0,h1); pk.y=pack2(h2,h3);
      *(uint2*)(hbuf+(size_t)r*1024+col)=pk; }
  }
}

__device__ __forceinline__ void phase_gemm_hy(KP kp_, int hf){ asm volatile("" : "+s"(kp_)); const Params p=load_params(kp_);
  const u16* hbuf=(const u16*)(p.ws+OFF_HBUF); const u16* wt=(const u16*)(p.ws+OFF_WTIN); u16* phyT=(u16*)(p.ws+OFF_PHYT); u16* PG=(u16*)p.out;
  int ntile = hf==0 ? 1024 : 512;
  for (int it=blockIdx.x; it<ntile; it+=gridDim.x){
    f32x4 acc[2][2][4][2];
    if (it<512){
      int q8=it&7, rt=it>>3; int g=q8>>1, tt=q8&1; int ct=16+g*4+hf*2+tt;
      gemm_core(hbuf, wt, rt*256, ct*256, acc);
      EPI_BEGIN
        int tok=rt*256+R0; int prow=g*512+tt*256+C0;
        if (g==3){ v[0]=siluf(v[0]); v[1]=siluf(v[1]); v[2]=siluf(v[2]); v[3]=siluf(v[3]); }
        uint2 pk; pk.x=pack2(v[0],v[1]); pk.y=pack2(v[2],v[3]);
        *(uint2*)(phyT+(size_t)prow*16384+tok)=pk;
      EPI_END
    } else {
      int j=it-512; int ct=32+(j&7), rt=j>>3;
      gemm_core(wt, hbuf, ct*256, rt*256, acc);
      EPI_BEGIN
        int np=ct*256+R0; int tok=rt*256+C0;
        uint2 pk; pk.x=pack2(sigmf(v[0]),sigmf(v[1])); pk.y=pack2(sigmf(v[2]),sigmf(v[3])); *(uint2*)(PG+(size_t)tok*2048+(np-8192))=pk;
      EPI_END
    }
  }
}

__device__ __forceinline__ float hconv3(const u16* __restrict__ row, int t, float w0, float w1, float w2, float bias){
  float m = bf2f(row[t]);
  int mi=__float_as_int(m);
  float l=__int_as_float(__builtin_amdgcn_update_dpp(0, mi, 0x138, 0xf, 0xf, false));
  float r=__int_as_float(__builtin_amdgcn_update_dpp(0, mi, 0x130, 0xf, 0xf, false));
  return w0*l+w1*m+w2*r+bias;
}
typedef _Float16 f16x8 __attribute__((ext_vector_type(8)));
__device__ __forceinline__ float2 ld_h2_coherent(const f16x2* ptr){
  unsigned u = __hip_atomic_load((const unsigned*)ptr, __ATOMIC_RELAXED, __HIP_MEMORY_SCOPE_AGENT);
  f16x2 h=__builtin_bit_cast(f16x2,u); return make_float2((float)h[0],(float)h[1]);
}
__device__ __forceinline__ void phase_hyena(KP kp_, int hf){ asm volatile("" : "+s"(kp_)); const Params p=load_params(kp_);
  int ftid=threadIdx.x; asm volatile("" : "+v"(ftid));
  int tid=ftid, lane=tid&63, wid=tid>>6;
  float2* Z=(float2*)smem; float* misc=(float*)(smem+131072);
  float2* twA=(float2*)(misc+512); float2* twB=(float2*)(misc+640);
  const float2* tw=(const float2*)(p.ws+OFF_TW);
  const _Float16* a3=(const _Float16*)(p.ws+OFF_A3);
  const u16* phyT=(const u16*)(p.ws+OFF_PHYT);
  u16* ybT=(u16*)(p.ws+OFF_YBT);
  char* scr=p.ws+OFF_FS+(size_t)blockIdx.x*196608;
  f16x2* H0p=(f16x2*)scr; f16x2* H1p=H0p+16384; float2* Zs=(float2*)(scr+131072);
  if (tid<64) twA[tid]=tw[tid*64]; else if (tid<128) twB[tid-64]=tw[tid-64];
  for (int cl=blockIdx.x; cl<512; cl+=gridDim.x){ int c=hf*512+cl;
    asm volatile("" : "+v"(tid)); lane=tid&63; wid=tid>>6;
    __syncthreads();
    if (tid<256){ int i=tid>>2, so=tid&3; misc[tid]=p.f_wout[(size_t)i*4096+(so>>1)*2048+(so&1)*1024+c]; }
    __syncthreads();
    const float lo=-3.0701134573253945f, hi=-15.350567286626973f;
    float sfrac=(float)c/1023.f;
    float delta=fabsf(lo*(1.f-sfrac)+hi*sfrac);
    const u16* rv=phyT+(size_t)cl*16384; const u16* r1=phyT+(size_t)(512+cl)*16384; const u16* r2=phyT+(size_t)(1024+cl)*16384; const u16* rz=phyT+(size_t)(1536+cl)*16384;
    float wv0=p.hy_conv_w[c], wv1=p.hy_conv_w[3072+c], wv2=p.hy_conv_w[6144+c], bv_=p.hy_conv_b[c];
    float wa0=p.hy_conv_w[1024+c], wa1=p.hy_conv_w[3072+1024+c], wa2=p.hy_conv_w[6144+1024+c], ba_=p.hy_conv_b[1024+c];
    float wb0=p.hy_conv_w[2048+c], wb1=p.hy_conv_w[3072+2048+c], wb2=p.hy_conv_w[6144+2048+c], bb_=p.hy_conv_b[2048+c];
    float bias0=p.hy_bias[c], bias1=p.hy_bias[1024+c];
    float nrm0=1.f, nrm1=1.f;
    _Pragma("unroll 1") for (int st=0; st<3; ++st){
      if (st==0){
    float ss0=0.f, ss1=0.f;
    {
      int n=lane&15, kg=lane>>4;
      f16x8 bw0, bw1;
      _Pragma("unroll") for (int e=0;e<8;++e){ bw0[e]=(n<4)?(_Float16)misc[(kg*8+e)*4+n]:(_Float16)0.f; bw1[e]=(n<4)?(_Float16)misc[(32+kg*8+e)*4+n]:(_Float16)0.f; }
      const float dsc=-delta*(1.f/8191.f);
      float pj0=__expf(dsc*(float)(kg*4)), pj1=__expf(dsc*(float)(kg*4+1)), pj2=__expf(dsc*(float)(kg*4+2)), pj3=__expf(dsc*(float)(kg*4+3));
      float* Zf=(float*)Z; float ssl=0.f; int order=n&1; bool side1=(n&2)!=0;
      _Pragma("unroll 8") for (int i=0;i<64;++i){ int tl=wid+8*i;
        const _Float16* ap=a3+(size_t)(tl*16+n)*64+kg*8;
        f16x8 a0=*(const f16x8*)ap, a1=*(const f16x8*)(ap+32);
        f32x4 dd={0.f,0.f,0.f,0.f};
        dd=__builtin_amdgcn_mfma_f32_16x16x32_f16(a0,bw0,dd,0,0,0);
        dd=__builtin_amdgcn_mfma_f32_16x16x32_f16(a1,bw1,dd,0,0,0);
        if (n<4){ float d0=__expf(dsc*(float)(tl*16)); int lag0=tl*16+kg*4;
          float v0=dd[0]*d0*pj0, v1=dd[1]*d0*pj1, v2=dd[2]*d0*pj2, v3=dd[3]*d0*pj3;
          if (!side1){ Zf[2*(lag0)+order]=v0; Zf[2*(lag0+1)+order]=v1; Zf[2*(lag0+2)+order]=v2; Zf[2*(lag0+3)+order]=v3; ssl+=v0*v0+v1*v1+v2*v2+v3*v3; }
          else { if (lag0>=1){ Zf[2*(16384-lag0)+order]=v0; ssl+=v0*v0; }
            Zf[2*(16384-lag0-1)+order]=v1; Zf[2*(16384-lag0-2)+order]=v2; Zf[2*(16384-lag0-3)+order]=v3; ssl+=v1*v1+v2*v2+v3*v3; } }
      }
      ss0=(n<4 && order==0)?ssl:0.f; ss1=(n<4 && order==1)?ssl:0.f;
    }
    if (tid==0) Z[8192]=make_float2(0.f,0.f);
    ss0=wave_sum(ss0); ss1=wave_sum(ss1);
    if (lane==0){ misc[256+wid*2]=ss0; misc[256+wid*2+1]=ss1; }
    __syncthreads();
    float t0=0.f,t1=0.f; for(int w=0;w<8;++w){ t0+=misc[256+w*2]; t1+=misc[256+w*2+1]; }
    nrm0=rsqrtf(t0+EPSV); nrm1=rsqrtf(t1+EPSV);
      }
      __syncthreads();
      if (st==0){ fft_pass<false,12>(Z,twA,twB,tid); }
      else if (st==1){ int tq=tid; asm volatile("" : "+v"(tq));
        _Pragma("unroll 4") for (int i=0;i<8;++i){ int t=tq+512*i;
          float2 a0=make_float2(hconv3(rv,t,wv0,wv1,wv2,bv_), hconv3(rv+8192,t,wv0,wv1,wv2,bv_));
          float2 a1=make_float2(hconv3(rv,t+4096,wv0,wv1,wv2,bv_), hconv3(rv+8192,t+4096,wv0,wv1,wv2,bv_));
          fwd12_padded(Z,twA,twB,t,a0,a1); }
        __syncthreads();
      } else { int tq=tid; asm volatile("" : "+v"(tq));
        _Pragma("unroll 4") for (int i=0;i<8;++i){ int t=tq+512*i; fwd12_padded(Z,twA,twB,t,Zs[t],Zs[t+4096]); }
        __syncthreads();
      }
      fft_fwd_head(Z,twA,twB,tid);
      if (st==0){
        fft_pass<false,0>(Z,twA,twB,tid);
    _Pragma("unroll 2") for (int i=0;i<8;++i){ int q0=(tid+512*i)*4; u32x4 h0w, h1w;
      _Pragma("unroll") for (int m=0;m<4;++m){ int q=q0+m; int k=rev4_14(q);
        float2 Fk=Z[q], Fn=Z[rev4_14((16384-k)&16383)];
        f16x2 h0v={(_Float16)(0.5f*nrm0*(Fk.x+Fn.x)),(_Float16)(0.5f*nrm0*(Fk.y-Fn.y))};
        f16x2 h1v={(_Float16)(0.5f*nrm1*(Fk.y+Fn.y)),(_Float16)(-0.5f*nrm1*(Fk.x-Fn.x))};
        unsigned u0=__builtin_bit_cast(unsigned,h0v), u1=__builtin_bit_cast(unsigned,h1v);
        h0w[m]=u0; h1w[m]=u1; }
      *(u32x4*)(H0p+q0)=h0w; *(u32x4*)(H1p+q0)=h1w; }
        __builtin_amdgcn_fence(__ATOMIC_ACQUIRE, "agent");
      } else {
        const f16x2* Hp = st==1 ? H0p : H1p;
        fft_mid(Z,Hp,tid);
        fft_inv_tail(Z,twA,twB,tid);
        if (st==1){ int tq=tid; asm volatile("" : "+v"(tq));
          _Pragma("unroll 4") for (int i=0;i<8;++i){ int tb=tq+512*i; float2 xr[2]; inv12_half(Z,twA,twB,tb,xr[0],xr[1]);
            _Pragma("unroll") for (int hh=0;hh<2;++hh){ int t=tb+hh*4096;
              float u0=hconv3(rv,t,wv0,wv1,wv2,bv_), u1=hconv3(rv+8192,t,wv0,wv1,wv2,bv_);
              float x0=hconv3(r1,t,wa0,wa1,wa2,ba_), x1=hconv3(r1+8192,t,wa0,wa1,wa2,ba_);
              float2 y=xr[hh]; y.x*=(1.f/16384.f); y.y*=(1.f/16384.f);
              Zs[t]=make_float2(x0*(y.x+u0*bias0), x1*(y.y+u1*bias0)); } }
        } else { int tq=tid; asm volatile("" : "+v"(tq));
          _Pragma("unroll 4") for (int i=0;i<8;++i){ int tb=tq+512*i; float2 xr[2]; inv12_half(Z,twA,twB,tb,xr[0],xr[1]);
            _Pragma("unroll") for (int hh=0;hh<2;++hh){ int t=tb+hh*4096;
              float x0=hconv3(r2,t,wb0,wb1,wb2,bb_), x1=hconv3(r2+8192,t,wb0,wb1,wb2,bb_);
              float2 y=xr[hh]; y.x*=(1.f/16384.f); y.y*=(1.f/16384.f); float2 z1=Zs[t];
              float o0=x0*(y.x+z1.x*bias1)*bf2f(rz[t]); float o1=x1*(y.y+z1.y*bias1)*bf2f(rz[8192+t]);
              ybT[(size_t)c*16384+t]=f2bf(o0); ybT[(size_t)c*16384+8192+t]=f2bf(o1); } }
        }
      }
      __syncthreads();
    }
  }
}

__device__ __forceinline__ void phase_ybt(KP kp_){ asm volatile("" : "+s"(kp_)); const Params p=load_params(kp_);
  int tid=threadIdx.x; asm volatile("" : "+v"(tid));
  const u16* ybT=(const u16*)(p.ws+OFF_YBT); u16* yb=(u16*)(p.ws+OFF_YB);
  u16* tile=(u16*)smem;
  for (int it=blockIdx.x; it<4096; it+=gridDim.x){
    int c0=(it&15)*64, t0=(it>>4)*64;
    __syncthreads();
    { int ch=tid>>3, t8=(tid&7)*8; *(u32x4*)(tile+ch*72+t8)=*(const u32x4*)(ybT+(size_t)(c0+ch)*16384+t0+t8); }
    __syncthreads();
    { int tk=tid>>3, c8=(tid&7)*8; u32x4 pk;
      _Pragma("unroll") for (int q=0;q<4;++q) pk[q]=(unsigned)tile[(c8+2*q)*72+tk] | ((unsigned)tile[(c8+2*q+1)*72+tk]<<16);
      *(u32x4*)(yb+(size_t)(t0+tk)*1024+c0+c8)=pk; }
  }
}

__device__ __forceinline__ void phase_gemm_dn(KP kp_){ asm volatile("" : "+s"(kp_)); const Params p=load_params(kp_);
  const u16* hbuf=(const u16*)(p.ws+OFF_HBUF); const u16* wt=(const u16*)(p.ws+OFF_WTIN);
  u16* R1=(u16*)(p.ws+OFF_R1); u16* ZA=(u16*)(p.ws+OFF_ZA); float* gates=(float*)(p.ws+OFF_GATES);
  for (int it=blockIdx.x; it<1056+66; it+=gridDim.x){
    int ct, rt;
    if (it<1056){ ct=it&15; rt=it>>4; } else { ct=40; rt=it-1056; }
    f32x4 acc[2][2][4][2];
    gemm_core(wt, hbuf, ct*256, rt*256, acc);
    EPI_BEGIN
      int np=ct*256+R0; int tok=rt*256+C0;
      if (ct<12){ uint2 pk; pk.x=pack2(v[0],v[1]); pk.y=pack2(v[2],v[3]); *(uint2*)(R1+(size_t)tok*3072+np)=pk; }
      else if (ct<16){ if (tok<16384){ uint2 pk; pk.x=pack2(siluf(v[0]),siluf(v[1])); pk.y=pack2(siluf(v[2]),siluf(v[3])); *(uint2*)(ZA+(size_t)tok*1024+(np-3072))=pk; } }
      else { int g=np-10240; if (g<32){ *(float4*)(gates+(size_t)tok*32+g)=make_float4(v[0],v[1],v[2],v[3]); } }
    EPI_END
  }
}

__device__ __forceinline__ void slot_bases(char* ws, int b, int cidx, int h, char*& bq, char*& bk, char*& bv, int& stride){
  if (cidx>=4){ int n=cidx-4; size_t tok0=(size_t)b*8192+n*64; char* base=ws+OFF_R1+tok0*6144+(size_t)h*256; bq=base; bk=base+2048; bv=base+4096; stride=6144; }
  else { char* base=ws+OFF_R1C+(size_t)((b*4+cidx)*8+h)*49152; bq=base; bk=base+16384; bv=base+32768; stride=256; }
}
__device__ __forceinline__ void phase_dnprep(KP kp_){ asm volatile("" : "+s"(kp_)); const Params p=load_params(kp_);
  float* raw=(float*)smem;
  float* tmp=(float*)(smem+34816);
  char* qs=smem+67584;
  char* ks=smem+84992;
  float* Lf=(float*)(smem+102400);
  float* Lb=(float*)(smem+118784);
  float* sm=(float*)(smem+135168);
  float *gcf=sm, *gcb=sm+64, *bef=sm+128, *beb=sm+192, *scl=sm+256;
  const u16* R1=(const u16*)(p.ws+OFF_R1); const float* gates=(const float*)(p.ws+OFF_GATES);
  u32x4 rp0,rp1,rp2; bool have_raw=false;
  for (int item=blockIdx.x; item<2112; item+=gridDim.x){
    int tid=threadIdx.x; asm volatile("" : "+v"(tid)); int lane=tid&63, wid=tid>>6;
    int b,n,h,cidx,tok0,rs,re;
    if (item<2048){ b=item>>10; n=(item>>3)&127; h=item&7; cidx=n+4; tok0=b*8192+n*64; rs=tok0; re=tok0+64; }
    else { int j=item-2048; b=j>>5; n=(j>>3)&3; h=j&7; cidx=n; tok0=16384+b*256+n*64; rs=16384+b*256; re=rs+256; }
    char *bq,*bk,*bv; int stride; slot_bases(p.ws,b,cidx,h,bq,bk,bv,stride);
    size_t ia=(size_t)((b*8+h)*132+cidx)*TA_STRIDE;
    char* taf=(char*)p.out+ia; char* tab=p.ws+OFF_TAB+ia;
    __syncthreads();
    if (wid==0){ const float* gr=gates+(size_t)(tok0+lane)*32;
      float bf_=1.f/(1.f+expf(-gr[h])), bb_=1.f/(1.f+expf(-gr[8+h]));
      float xf=gr[16+h]+p.dn_dt_bias[h], xb=gr[24+h]+p.dn_dt_bias[8+h];
      float spf=xf>20.f?xf:log1pf(expf(xf)), spb=xb>20.f?xb:log1pf(expf(xb));
      float gf=-expf(p.dn_a_log[h])*spf, gb=-expf(p.dn_a_log[8+h])*spb;
      for (int o=1;o<64;o<<=1){ float t=__shfl_up(gf,o); if (lane>=o) gf+=t; float u=__shfl_down(gb,o); if (lane+o<64) gb+=u; }
      gcf[lane]=gf; gcb[lane]=gb; bef[lane]=bf_; beb[lane]=bb_;
      *(float*)(taf+24576+lane*4)=gf; *(float*)(tab+24576+lane*4)=gb; }
#define RAWLOAD_AT(w_,tok0,rs,re,h) { const u16* rb=R1+(size_t)(w_)*1024+(h)*128; \
      { int e=tid; int i=e>>4, c8=(e&15)*8; int tk=tok0-2+i; rp0=u32x4{0,0,0,0}; if (tk>=rs && tk<re) rp0=*(const u32x4*)(rb+(size_t)tk*3072+c8); } \
      { int e=tid+512; int i=e>>4, c8=(e&15)*8; int tk=tok0-2+i; rp1=u32x4{0,0,0,0}; if (tk>=rs && tk<re) rp1=*(const u32x4*)(rb+(size_t)tk*3072+c8); } \
      { int e=tid+1024; int i=e>>4, c8=(e&15)*8; int tk=tok0-2+i; rp2=u32x4{0,0,0,0}; if (e<1088 && tk>=rs && tk<re) rp2=*(const u32x4*)(rb+(size_t)tk*3072+c8); } }
#define RAWPUT1(rp_,e_) { int e=(e_); if (e<1088){ int i=e>>4, c8=(e&15)*8; float* d=raw+i*128+c8; \
      d[0]=__uint_as_float(rp_[0]<<16); d[1]=__uint_as_float(rp_[0]&0xffff0000u); d[2]=__uint_as_float(rp_[1]<<16); d[3]=__uint_as_float(rp_[1]&0xffff0000u); \
      d[4]=__uint_as_float(rp_[2]<<16); d[5]=__uint_as_float(rp_[2]&0xffff0000u); d[6]=__uint_as_float(rp_[3]<<16); d[7]=__uint_as_float(rp_[3]&0xffff0000u); } }
#define RAWLOAD(w_) RAWLOAD_AT(w_,tok0,rs,re,h)
#define ITEM_DECODE(it_,b_,n_,h_,cidx_,tok0_,rs_,re_) { if ((it_)<2048){ b_=(it_)>>10; n_=((it_)>>3)&127; h_=(it_)&7; cidx_=n_+4; tok0_=b_*8192+n_*64; rs_=tok0_; re_=tok0_+64; } \
      else { int j_=(it_)-2048; b_=j_>>5; n_=(j_>>3)&3; h_=j_&7; cidx_=n_; tok0_=16384+b_*256+n_*64; rs_=16384+b_*256; re_=rs_+256; } }
    if (!have_raw) RAWLOAD(0);
    _Pragma("unroll 1") for (int which=0; which<3; ++which){
      asm volatile("" : "+v"(tid));
      RAWPUT1(rp0,tid); RAWPUT1(rp1,tid+512); RAWPUT1(rp2,tid+1024);
      if (which<2) RAWLOAD(which+1);
      __syncthreads();
      int c=tid&127, tg=tid>>7; int ch=which*1024+h*128+c;
      float w0=p.dn_conv_w[ch], w1=p.dn_conv_w[3072+ch], w2=p.dn_conv_w[6144+ch], w3=p.dn_conv_w[9216+ch], w4=p.dn_conv_w[12288+ch];
      float o16[16];
      { float rw[20];
        _Pragma("unroll") for (int i=0;i<20;++i) rw[i]=raw[(tg*16+i)*128+c];
        _Pragma("unroll") for (int i=0;i<16;++i){
          float a=w0*rw[i]+w1*rw[i+1]+w2*rw[i+2]+w3*rw[i+3]+w4*rw[i+4];
          o16[i]=a/(1.f+__expf(-a)); } }
      if (which==2){
        char* dst=bv+(size_t)(c>>1)*stride+(c&1)*128+tg*32;
        uint4 p0, p1;
        p0.x=pack2(o16[0],o16[1]); p0.y=pack2(o16[2],o16[3]); p0.z=pack2(o16[4],o16[5]); p0.w=pack2(o16[6],o16[7]);
        p1.x=pack2(o16[8],o16[9]); p1.y=pack2(o16[10],o16[11]); p1.z=pack2(o16[12],o16[13]); p1.w=pack2(o16[14],o16[15]);
        *(uint4*)dst=p0; *(uint4*)(dst+16)=p1;
      } else {
        _Pragma("unroll") for (int i=0;i<16;++i) tmp[(tg*16+i)*128+c]=o16[i];
        __syncthreads();
        { int t=tid>>3, c0=(tid&7)*16; float ss=0.f;
          _Pragma("unroll") for(int cc=0;cc<16;++cc){ float s_=tmp[t*128+c0+cc]; ss+=s_*s_; }
          ss+=__shfl_xor(ss,1); ss+=__shfl_xor(ss,2); ss+=__shfl_xor(ss,4);
          if ((tid&7)==0) scl[t]=rsqrtf(ss+EPSV)*(which==0?0.08838834764831845f:1.f); }
        __syncthreads();
        char* sdst= which==0?qs:ks;
        _Pragma("unroll") for (int i=0;i<16;++i){ o16[i]*=scl[tg*16+i]; *(u16*)(sdst+(tg*16+i)*272+c*2)=f2bf(o16[i]); }
        if (which==0){ _Pragma("unroll") for (int i=0;i<16;++i) *(u16*)(bq+(size_t)(tg*16+i)*stride+c*2)=f2bf(o16[i]); }
        else { char* dst=bk+(size_t)(c>>1)*stride+(c&1)*128+tg*32;
          uint4 p0, p1;
          p0.x=pack2(o16[0],o16[1]); p0.y=pack2(o16[2],o16[3]); p0.z=pack2(o16[4],o16[5]); p0.w=pack2(o16[6],o16[7]);
          p1.x=pack2(o16[8],o16[9]); p1.y=pack2(o16[10],o16[11]); p1.z=pack2(o16[12],o16[13]); p1.w=pack2(o16[14],o16[15]);
          *(uint4*)dst=p0; *(uint4*)(dst+16)=p1; }
      }
      __syncthreads();
    }
    { int nx=item+gridDim.x; have_raw=false;
      if (nx<2112){ int b2,n2,h2,c2,t2,rs2,re2; ITEM_DECODE(nx,b2,n2,h2,c2,t2,rs2,re2); (void)c2; RAWLOAD_AT(0,t2,rs2,re2,h2); have_raw=true; } }
    { int r=lane&15, kg=lane>>4;
      for (int tt=0; tt<2; ++tt){ int t=wid*2+tt; int mt=t>>2, nt=t&3;
        f32x4 akk={0.f,0.f,0.f,0.f}, aqk={0.f,0.f,0.f,0.f};
        _Pragma("unroll") for (int k4=0;k4<4;++k4){
          bf16x8 Bk=*(const bf16x8*)(ks+(nt*16+r)*272+(k4*32+kg*8)*2);
          bf16x8 Ak=*(const bf16x8*)(ks+(mt*16+r)*272+(k4*32+kg*8)*2);
          bf16x8 Aq=*(const bf16x8*)(qs+(mt*16+r)*272+(k4*32+kg*8)*2);
          akk=__builtin_amdgcn_mfma_f32_16x16x32_bf16(Ak,Bk,akk,0,0,0);
          aqk=__builtin_amdgcn_mfma_f32_16x16x32_bf16(Aq,Bk,aqk,0,0,0); }
        int jj=nt*16+r; float gfj=gcf[jj], gbj=gcb[jj];
        _Pragma("unroll") for (int j=0;j<4;++j){ int i=mt*16+kg*4+j;
          float ef=__expf(fminf(gcf[i]-gfj,0.f)), eb=__expf(fminf(gcb[i]-gbj,0.f));
          float lf=(jj<i)?bef[i]*akk[j]*ef:0.f;
          float af=(jj<=i)?aqk[j]*ef:0.f;
          float lb=(jj>i)?beb[i]*akk[j]*eb:0.f;
          float ab=(jj>=i)?aqk[j]*eb:0.f;
          Lf[i*64+jj]=lf; Lb[(63-i)*64+(63-jj)]=lb;
          *(u16*)(taf+16384+(i*64+jj)*2)=f2bf(af); *(u16*)(tab+16384+(i*64+jj)*2)=f2bf(ab); }
      } }
    __syncthreads();
    if (wid<2){
      int lbase = wid==0 ? 102400 : 118784; asm volatile("" : "+v"(lbase));
      float Tc[64];
      float4 lcur[16], lnxt[16];
      _Pragma("unroll") for (int r4=0;r4<16;++r4){ lcur[r4]=make_float4(0.f,0.f,0.f,0.f); lnxt[r4]=lcur[r4]; }
      _Pragma("unroll") for (int r=0;r<64;++r){
        if (r+1<64){ _Pragma("unroll") for (int r4=0;r4<(r+1+3)/4;++r4) lnxt[r4]=*(const float4*)(smem+lbase+((r+1)*64+r4*4)*4); }
        float a0=(r==lane)?1.f:0.f, a1=0.f, a2=0.f, a3=0.f;
        _Pragma("unroll") for (int r4=0;r4<(r+3)/4;++r4){ float4 l=lcur[r4];
          if (r4*4+0<r) a0-=l.x*Tc[r4*4+0]; if (r4*4+1<r) a1-=l.y*Tc[r4*4+1]; if (r4*4+2<r) a2-=l.z*Tc[r4*4+2]; if (r4*4+3<r) a3-=l.w*Tc[r4*4+3]; }
        Tc[r]=(a0+a1)+(a2+a3);
        _Pragma("unroll") for (int r4=0;r4<16;++r4) lcur[r4]=lnxt[r4];
        asm volatile("":::"memory"); }
      if (wid==0){ int c=lane; float su=bef[c], sw=su*__expf(gcf[c]);
        _Pragma("unroll") for (int r=0;r<64;++r){ *(u16*)(taf+(r*64+c)*2)=f2bf(Tc[r]*sw); *(u16*)(taf+8192+(r*64+c)*2)=f2bf(Tc[r]*su); } }
      else { int j=63-lane; float su=beb[j], sw=su*__expf(gcb[j]);
        _Pragma("unroll") for (int r=0;r<64;++r){ int i=63-r; *(u16*)(tab+(i*64+j)*2)=f2bf(Tc[r]*sw); *(u16*)(tab+8192+(i*64+j)*2)=f2bf(Tc[r]*su); } }
    }
  }
}

#define SQ 0
#define SKT 17408
#define SVT 35840
#define STW 54272
#define STU 63488
#define SAT 72704
#define SGC 81920
#define SWB 82176
__device__ __forceinline__ bf16x8 lds128(int off){ return *(const bf16x8*)(smem+off); }
__device__ __forceinline__ bf16x8 lds64x2(int off){ uint2 a=*(const uint2*)(smem+off), b=*(const uint2*)(smem+off+32); u32x4 t={a.x,a.y,b.x,b.y}; return __builtin_bit_cast(bf16x8,t); }
__device__ __forceinline__ bf16x8 packfrag(f32x4 d0, f32x4 d1){ u32x4 t={pack2(d0[0],d0[1]),pack2(d0[2],d0[3]),pack2(d1[0],d1[1]),pack2(d1[2],d1[3])}; return __builtin_bit_cast(bf16x8,t); }
#define MF(a,b,c) __builtin_amdgcn_mfma_f32_16x16x32_bf16(a,b,c,0,0,0)
__device__ __forceinline__ void phase_scan(KP kp_){ asm volatile("" : "+s"(kp_)); const Params p=load_params(kp_);
  int ftid=threadIdx.x; asm volatile("" : "+v"(ftid));
  int tid=ftid, lane=tid&63, wv=tid>>6, r=lane&15, kg=lane>>4;
  for (int item=blockIdx.x; item<32; item+=gridDim.x){
    int d=item&1, h=(item>>1)&7, b=item>>4;
    char* tabase = d ? (p.ws+OFF_TAB) : (char*)p.out;
    f32x4 Sacc[8];
    _Pragma("unroll") for (int i=0;i<8;++i) Sacc[i]=f32x4{0.f,0.f,0.f,0.f};
    u32x4 pq0A,pq1A,pk0A,pk1A,pv0A,pv1A,pt0A,pt1A,pt2A; float pgA;
    u32x4 pq0B,pq1B,pk0B,pk1B,pv0B,pv1B,pt0B,pt1B,pt2B; float pgB;
#define PREFETCH(X,s_) { int s__=(s_); int cidx=s__<4?(d?3-s__:s__):4+(d?131-s__:s__-4); char *bq,*bk,*bv; int stride; slot_bases(p.ws,b,cidx,h,bq,bk,bv,stride); \
      const char* ta=tabase+(size_t)((b*8+h)*132+cidx)*TA_STRIDE; \
      { int e=tid; pq0##X=*(const u32x4*)(bq+(size_t)(e>>4)*stride+(e&15)*16); int row=e>>3; size_t ko=(size_t)(row>>1)*stride+(row&1)*128+(e&7)*16; pk0##X=*(const u32x4*)(bk+ko); pv0##X=*(const u32x4*)(bv+ko); } \
      { int e=tid+512; pq1##X=*(const u32x4*)(bq+(size_t)(e>>4)*stride+(e&15)*16); int row=e>>3; size_t ko=(size_t)(row>>1)*stride+(row&1)*128+(e&7)*16; pk1##X=*(const u32x4*)(bk+ko); pv1##X=*(const u32x4*)(bv+ko); } \
      pt0##X=*(const u32x4*)(ta+tid*16); pt1##X=*(const u32x4*)(ta+8192+tid*16); pt2##X=*(const u32x4*)(ta+16384+tid*16); \
      pg##X = tid<64 ? *(const float*)(ta+24576+tid*4) : 0.f; }
#define FILL(X) { { int e=tid; *(u32x4*)(smem+SQ+(e>>4)*272+(e&15)*16)=pq0##X; int row=e>>3; *(u32x4*)(smem+SKT+row*144+(e&7)*16)=pk0##X; *(u32x4*)(smem+SVT+row*144+(e&7)*16)=pv0##X; } \
      { int e=tid+512; *(u32x4*)(smem+SQ+(e>>4)*272+(e&15)*16)=pq1##X; int row=e>>3; *(u32x4*)(smem+SKT+row*144+(e&7)*16)=pk1##X; *(u32x4*)(smem+SVT+row*144+(e&7)*16)=pv1##X; } \
      { int row=tid>>3, c16=tid&7; *(u32x4*)(smem+STW+row*144+c16*16)=pt0##X; *(u32x4*)(smem+STU+row*144+c16*16)=pt1##X; *(u32x4*)(smem+SAT+row*144+c16*16)=pt2##X; } \
      if (tid<64) *(float*)(smem+SGC+tid*4)=pg##X; }
    __syncthreads();
    PREFETCH(A,0); FILL(A);
    __syncthreads();
    for (int s2=0; s2<132; s2+=2){
      { const int s=s2;
        if (s+1<132) PREFETCH(A,s+1);
      f32x4 wacc[4], vn[4];
      _Pragma("unroll") for (int i=0;i<4;++i){ wacc[i]=f32x4{0.f,0.f,0.f,0.f}; vn[i]=f32x4{0.f,0.f,0.f,0.f}; }
      _Pragma("unroll") for (int ks=0;ks<2;++ks){ int kb=(ks*32+kg*8)*2;
        bf16x8 A=lds128(SKT+(wv*16+r)*144+kb);
        bf16x8 Bv=lds128(SVT+(wv*16+r)*144+kb);
        _Pragma("unroll") for (int t=0;t<4;++t){
          wacc[t]=MF(A, lds128(STW+(t*16+r)*144+kb), wacc[t]);
          vn[t]=MF(lds128(STU+(t*16+r)*144+kb), Bv, vn[t]); } }
      _Pragma("unroll") for (int t=0;t<4;++t){ uint2 pk2; pk2.x=pack2(-wacc[t][0],-wacc[t][1]); pk2.y=pack2(-wacc[t][2],-wacc[t][3]);
        *(uint2*)(smem+SWB+(t*16+r)*272+(wv*16+kg*4)*2)=pk2; }
      __syncthreads();
      bf16x8 Sf[4];
      _Pragma("unroll") for (int q=0;q<4;++q) Sf[q]=packfrag(Sacc[2*q],Sacc[2*q+1]);
      f32x4 oacc[4];
      _Pragma("unroll") for (int i=0;i<4;++i) oacc[i]=f32x4{0.f,0.f,0.f,0.f};
      _Pragma("unroll") for (int q=0;q<4;++q){ int kb=(32*q+kg*4)*2;
        _Pragma("unroll") for (int t=0;t<4;++t){
          vn[t]=MF(lds64x2(SWB+(t*16+r)*272+kb), Sf[q], vn[t]);
          oacc[t]=MF(lds64x2(SQ+(t*16+r)*272+kb), Sf[q], oacc[t]); } }
      const float* gcs=(const float*)(smem+SGC);
      float gl = d ? gcs[0] : gcs[63];
      float gam=__expf(gl);
      f32x4 vs[4];
      _Pragma("unroll") for (int t=0;t<4;++t){ float4 g4=*(const float4*)(gcs+t*16+kg*4);
        oacc[t][0]*=__expf(g4.x); oacc[t][1]*=__expf(g4.y); oacc[t][2]*=__expf(g4.z); oacc[t][3]*=__expf(g4.w);
        vs[t][0]=vn[t][0]*__expf(gl-g4.x); vs[t][1]=vn[t][1]*__expf(gl-g4.y); vs[t][2]=vn[t][2]*__expf(gl-g4.z); vs[t][3]=vn[t][3]*__expf(gl-g4.w); }
      bf16x8 Vf[2], Wf[2];
      _Pragma("unroll") for (int q=0;q<2;++q){ Vf[q]=packfrag(vn[2*q],vn[2*q+1]); Wf[q]=packfrag(vs[2*q],vs[2*q+1]); }
      _Pragma("unroll") for (int q=0;q<2;++q){ int kb=(32*q+kg*4)*2;
        _Pragma("unroll") for (int t=0;t<4;++t) oacc[t]=MF(lds64x2(SAT+(t*16+r)*144+kb), Vf[q], oacc[t]); }
      _Pragma("unroll") for (int m8=0;m8<8;++m8){ Sacc[m8][0]*=gam; Sacc[m8][1]*=gam; Sacc[m8][2]*=gam; Sacc[m8][3]*=gam; }
      _Pragma("unroll") for (int q=0;q<2;++q){ int kb=(32*q+kg*4)*2;
        _Pragma("unroll") for (int m8=0;m8<8;++m8) Sacc[m8]=MF(lds64x2(SKT+(m8*16+r)*144+kb), Wf[q], Sacc[m8]); }
      if (s>=4){ int cidx=4+(d?131-s:s-4); char* op=tabase+(size_t)((b*8+h)*132+cidx)*TA_STRIDE;
        _Pragma("unroll") for (int t=0;t<4;++t) _Pragma("unroll") for (int j=0;j<4;++j)
          *(u16*)(op+((t*16+kg*4+j)*128+wv*16+r)*2)=f2bf(oacc[t][j]); }
        __syncthreads();
        FILL(A);
        __syncthreads();
      }
      { const int s=s2+1;
        if (s+1<132) PREFETCH(A,s+1);
      f32x4 wacc[4], vn[4];
      _Pragma("unroll") for (int i=0;i<4;++i){ wacc[i]=f32x4{0.f,0.f,0.f,0.f}; vn[i]=f32x4{0.f,0.f,0.f,0.f}; }
      _Pragma("unroll") for (int ks=0;ks<2;++ks){ int kb=(ks*32+kg*8)*2;
        bf16x8 A=lds128(SKT+(wv*16+r)*144+kb);
        bf16x8 Bv=lds128(SVT+(wv*16+r)*144+kb);
        _Pragma("unroll") for (int t=0;t<4;++t){
          wacc[t]=MF(A, lds128(STW+(t*16+r)*144+kb), wacc[t]);
          vn[t]=MF(lds128(STU+(t*16+r)*144+kb), Bv, vn[t]); } }
      _Pragma("unroll") for (int t=0;t<4;++t){ uint2 pk2; pk2.x=pack2(-wacc[t][0],-wacc[t][1]); pk2.y=pack2(-wacc[t][2],-wacc[t][3]);
        *(uint2*)(smem+SWB+(t*16+r)*272+(wv*16+kg*4)*2)=pk2; }
      __syncthreads();
      bf16x8 Sf[4];
      _Pragma("unroll") for (int q=0;q<4;++q) Sf[q]=packfrag(Sacc[2*q],Sacc[2*q+1]);
      f32x4 oacc[4];
      _Pragma("unroll") for (int i=0;i<4;++i) oacc[i]=f32x4{0.f,0.f,0.f,0.f};
      _Pragma("unroll") for (int q=0;q<4;++q){ int kb=(32*q+kg*4)*2;
        _Pragma("unroll") for (int t=0;t<4;++t){
          vn[t]=MF(lds64x2(SWB+(t*16+r)*272+kb), Sf[q], vn[t]);
          oacc[t]=MF(lds64x2(SQ+(t*16+r)*272+kb), Sf[q], oacc[t]); } }
      const float* gcs=(const float*)(smem+SGC);
      float gl = d ? gcs[0] : gcs[63];
      float gam=__expf(gl);
      f32x4 vs[4];
      _Pragma("unroll") for (int t=0;t<4;++t){ float4 g4=*(const float4*)(gcs+t*16+kg*4);
        oacc[t][0]*=__expf(g4.x); oacc[t][1]*=__expf(g4.y); oacc[t][2]*=__expf(g4.z); oacc[t][3]*=__expf(g4.w);
        vs[t][0]=vn[t][0]*__expf(gl-g4.x); vs[t][1]=vn[t][1]*__expf(gl-g4.y); vs[t][2]=vn[t][2]*__expf(gl-g4.z); vs[t][3]=vn[t][3]*__expf(gl-g4.w); }
      bf16x8 Vf[2], Wf[2];
      _Pragma("unroll") for (int q=0;q<2;++q){ Vf[q]=packfrag(vn[2*q],vn[2*q+1]); Wf[q]=packfrag(vs[2*q],vs[2*q+1]); }
      _Pragma("unroll") for (int q=0;q<2;++q){ int kb=(32*q+kg*4)*2;
        _Pragma("unroll") for (int t=0;t<4;++t) oacc[t]=MF(lds64x2(SAT+(t*16+r)*144+kb), Vf[q], oacc[t]); }
      _Pragma("unroll") for (int m8=0;m8<8;++m8){ Sacc[m8][0]*=gam; Sacc[m8][1]*=gam; Sacc[m8][2]*=gam; Sacc[m8][3]*=gam; }
      _Pragma("unroll") for (int q=0;q<2;++q){ int kb=(32*q+kg*4)*2;
        _Pragma("unroll") for (int m8=0;m8<8;++m8) Sacc[m8]=MF(lds64x2(SKT+(m8*16+r)*144+kb), Wf[q], Sacc[m8]); }
      if (s>=4){ int cidx=4+(d?131-s:s-4); char* op=tabase+(size_t)((b*8+h)*132+cidx)*TA_STRIDE;
        _Pragma("unroll") for (int t=0;t<4;++t) _Pragma("unroll") for (int j=0;j<4;++j)
          *(u16*)(op+((t*16+kg*4+j)*128+wv*16+r)*2)=f2bf(oacc[t][j]); }
        __syncthreads();
        if (s+1<132) FILL(A);
        __syncthreads();
      }
    }
  }
}

__device__ __forceinline__ void phase_oa(KP kp_){ asm volatile("" : "+s"(kp_)); const Params p=load_params(kp_);
  int ftid=threadIdx.x; asm volatile("" : "+v"(ftid));
  int lane=ftid&63, wid=ftid>>6;
  const char* taf=(const char*)p.out; const char* tab=(const char*)(p.ws+OFF_TAB);
  u16* ZA=(u16*)(p.ws+OFF_ZA);
  float g0=p.dn_norm_g[lane*2], g1=p.dn_norm_g[lane*2+1];
  _Pragma("unroll 4") for (int it=blockIdx.x*8+wid; it<16384*8; it+=gridDim.x*8){
    int tok=it>>3, h=it&7; int b=tok>>13, n=(tok>>6)&127, tl=tok&63;
    size_t ia=(size_t)((b*8+h)*132+4+n)*TA_STRIDE + (size_t)(tl*128+lane*2)*2;
    unsigned a=*(const unsigned*)(taf+ia), bb=*(const unsigned*)(tab+ia);
    size_t off=(size_t)it*128+lane*2;
    unsigned z=*(const unsigned*)(ZA+off);
    float o0=bf2f((u16)(a&0xffff))+bf2f((u16)(bb&0xffff)), o1=bf2f((u16)(a>>16))+bf2f((u16)(bb>>16));
    float ss=wave_sum(o0*o0+o1*o1); float r=rsqrtf(ss*(1.f/128.f)+EPSV);
    float r0=o0*r*g0*bf2f((u16)(z&0xffff)), r1=o1*r*g1*bf2f((u16)(z>>16));
    *(unsigned*)(ZA+off)=pack2(r0,r1);
  }
}

__device__ __forceinline__ void phase_merge(KP kp_){ asm volatile("" : "+s"(kp_)); const Params p=load_params(kp_);
  const u16* oa=(const u16*)(p.ws+OFF_OA); const u16* yb=(const u16*)(p.ws+OFF_YB);
  const u16* wpa=(const u16*)(p.ws+OFF_WTPA); const u16* wpb=(const u16*)(p.ws+OFF_WTPB);
  const u16* PG=(const u16*)p.out; float* MA=(float*)(p.ws+OFF_MA); u16* M=(u16*)(p.ws+OFF_M);
  for (int it=blockIdx.x; it<256; it+=gridDim.x){
    int ct=it&3, rt=it>>2;
    f32x4 acc[2][2][4][2];
    gemm_core(wpa, oa, ct*256, rt*256, acc);
    EPIG_BEGIN
      uint2 g[8];
      EPIG_FOR g[idx]=*(const uint2*)(PG+(size_t)(rt*256+C0)*2048+ct*256+R0); EPIG_ENDFOR
      EPIG_FOR f32x4 v=acc[ai][bj][m][n]; uint2 gg=g[idx];
        float4 r; r.x=v[0]*bf2f((u16)(gg.x&0xffff)); r.y=v[1]*bf2f((u16)(gg.x>>16)); r.z=v[2]*bf2f((u16)(gg.y&0xffff)); r.w=v[3]*bf2f((u16)(gg.y>>16));
        *(float4*)(MA+(size_t)(rt*256+C0)*1024+ct*256+R0)=r; EPIG_ENDFOR
    EPIG_END
  }
  for (int it=blockIdx.x; it<256; it+=gridDim.x){
    int ct=it&3, rt=it>>2;
    f32x4 acc[2][2][4][2];
    gemm_core(wpb, yb, ct*256, rt*256, acc);
    EPIG_BEGIN
      uint2 g[8]; float4 ra[8];
      EPIG_FOR g[idx]=*(const uint2*)(PG+(size_t)(rt*256+C0)*2048+1024+ct*256+R0); ra[idx]=*(const float4*)(MA+(size_t)(rt*256+C0)*1024+ct*256+R0); EPIG_ENDFOR
      EPIG_FOR f32x4 v=acc[ai][bj][m][n]; uint2 gg=g[idx]; float4 r=ra[idx];
        r.x+=v[0]*bf2f((u16)(gg.x&0xffff)); r.y+=v[1]*bf2f((u16)(gg.x>>16)); r.z+=v[2]*bf2f((u16)(gg.y&0xffff)); r.w+=v[3]*bf2f((u16)(gg.y>>16));
        uint2 pk; pk.x=pack2(r.x,r.y); pk.y=pack2(r.z,r.w);
        *(uint2*)(M+(size_t)(rt*256+C0)*1024+ct*256+R0)=pk; EPIG_ENDFOR
    EPIG_END
  }
}
__device__ __forceinline__ void phase_out(KP kp_){ asm volatile("" : "+s"(kp_)); const Params p=load_params(kp_);
  const u16* M=(const u16*)(p.ws+OFF_M); const u16* wo=(const u16*)(p.ws+OFF_WTOUT);
  const float* modv=(const float*)(p.ws+OFF_MOD);
  for (int it=blockIdx.x; it<256; it+=gridDim.x){
    int ct=it&3, rt=it>>2;
    f32x4 acc[2][2][4][2];
    gemm_core(wo, M, ct*256, rt*256, acc);
    EPIG_BEGIN
      float4 xa[8], ga[8];
      EPIG_FOR int tok=rt*256+C0; xa[idx]=*(const float4*)(p.x+(size_t)tok*1024+ct*256+R0); ga[idx]=*(const float4*)(modv+(tok>>13)*3072+2048+ct*256+R0); EPIG_ENDFOR
      EPIG_FOR f32x4 v=acc[ai][bj][m][n]; float4 xv=xa[idx], gt=ga[idx];
        float4 r; r.x=xv.x+gt.x*v[0]; r.y=xv.y+gt.y*v[1]; r.z=xv.z+gt.z*v[2]; r.w=xv.w+gt.w*v[3];
        *(float4*)(p.out+(size_t)(rt*256+C0)*1024+ct*256+R0)=r; EPIG_ENDFOR
    EPIG_END
  }
}

__device__ __forceinline__ void phase_final(KP kp_){ asm volatile("" : "+s"(kp_)); const Params p=load_params(kp_);
  int ftid=threadIdx.x; asm volatile("" : "+v"(ftid));
  int lane=ftid&63, wid=ftid>>6;
  _Pragma("unroll 2") for (int r=blockIdx.x*8+wid; r<16384; r+=gridDim.x*8){
    float4 xv[4]; float ss=0.f;
    for(int i=0;i<4;++i){ xv[i]=*(const float4*)(p.out+(size_t)r*1024+lane*4+256*i); ss+=xv[i].x*xv[i].x+xv[i].y*xv[i].y+xv[i].z*xv[i].z+xv[i].w*xv[i].w; }
    ss=wave_sum(ss); float rstd=rsqrtf(ss*(1.f/1024.f)+EPSV);
    for(int i=0;i<4;++i){ int col=lane*4+256*i; float4 v=xv[i]; float4 g=*(const float4*)(p.final_g+col);
      v.x*=rstd*g.x; v.y*=rstd*g.y; v.z*=rstd*g.z; v.w*=rstd*g.w; *(float4*)(p.out+(size_t)r*1024+col)=v; }
  }
}

#define XB_TMO      128
#define XB_XCNT(j)  (256  + 64 * (j))
#define XB_XSUB(j)  (1280 + 64 * (j))
#define XB_XGEN(j)  (2304 + 64 * (j))
#define XB_TOP      3328
#define XB_TOPGEN   3392
#define XCD_BAR_WORDS 3456
#define XB_SPIN_CAP (1u << 18)
#define LAS __attribute__((address_space(3)))

__device__ __forceinline__ unsigned xb_ld(unsigned* p)              { return __hip_atomic_load(p, __ATOMIC_RELAXED, __HIP_MEMORY_SCOPE_AGENT); }
__device__ __forceinline__ unsigned xb_add(unsigned* p, unsigned v) { return __hip_atomic_fetch_add(p, v, __ATOMIC_RELAXED, __HIP_MEMORY_SCOPE_AGENT); }
__device__ __forceinline__ unsigned xb_xcc_id() { return (unsigned)__builtin_amdgcn_s_getreg((3 << 11) | 20) & 0xFu; }
#define XB_SPIN(cond, bar) do { unsigned _sp = 0; while (cond) { __builtin_amdgcn_s_sleep(1); \
    if ((++_sp & 255u) == 0u) { if (xb_ld(&(bar)[XB_TMO])) break; if (_sp > XB_SPIN_CAP) { atomicAdd(&(bar)[XB_TMO], 1u); break; } } } } while (0)

struct XcdBarrier {
    unsigned* bar; unsigned x;
    volatile LAS unsigned* st;
};

__device__ __forceinline__ XcdBarrier xcd_barrier_post(unsigned* bar, volatile LAS unsigned* st) {
    XcdBarrier b; b.bar = bar; b.x = xb_xcc_id(); b.st = st;
    if (threadIdx.x == 0) (void)xb_add(&bar[XB_XCNT(b.x)], 1u);
    return b;
}
__device__ __forceinline__ void xcd_barrier_complete(unsigned* bar, unsigned x, unsigned& nloc, unsigned& nx) {
    const unsigned G = gridDim.x * gridDim.y * gridDim.z;
    unsigned sum, cnt, mine, sp = 0u;
    for (;;) {
        sum = 0u; cnt = 0u; mine = 0u;
#pragma unroll
        for (unsigned j = 0; j < 16; ++j) { const unsigned c = xb_ld(&bar[XB_XCNT(j)]); sum += c; cnt += (c > 0u) ? 1u : 0u; mine = (j == x) ? c : mine; }
        if (sum == G) break;
        __builtin_amdgcn_s_sleep(1);
        if ((++sp & 255u) == 0u) { if (xb_ld(&bar[XB_TMO])) break; if (sp > XB_SPIN_CAP) { atomicAdd(&bar[XB_TMO], 1u); break; } }
    }
    nloc = mine > 0u ? mine : 1u; nx = cnt > 0u ? cnt : 1u;
}

__device__ __forceinline__ void xcd_barrier(const XcdBarrier& b) {
    asm volatile("s_waitcnt vmcnt(0)" ::: "memory");
    __syncthreads();
    if (threadIdx.x == 0) {
        unsigned* bar = b.bar;
        __builtin_amdgcn_s_waitcnt(0);
        unsigned nloc = b.st[0], nx = b.st[1];
        if (nloc == 0u) { xcd_barrier_complete(bar, b.x, nloc, nx); b.st[0] = nloc; b.st[1] = nx; }
        const unsigned old = xb_add(&bar[XB_XSUB(b.x)], 1u);
        const unsigned gen = old / nloc;
        if (old + 1u == (gen + 1u) * nloc) {
            __builtin_amdgcn_fence(__ATOMIC_RELEASE, "agent");
            asm volatile("s_waitcnt vmcnt(0)" ::: "memory");
            const unsigned og = xb_add(&bar[XB_TOP], 1u);
            const unsigned tg = og / nx;
            if (og + 1u == (tg + 1u) * nx) xb_add(&bar[XB_TOPGEN], 1u);
            else XB_SPIN(xb_ld(&bar[XB_TOPGEN]) == tg, bar);
            __builtin_amdgcn_fence(__ATOMIC_ACQUIRE, "agent");
            xb_add(&bar[XB_XGEN(b.x)], 1u);
            asm volatile("s_waitcnt vmcnt(0)" ::: "memory");
        } else {
            XB_SPIN(xb_ld(&bar[XB_XGEN(b.x)]) == gen, bar);
            __builtin_amdgcn_fence(__ATOMIC_ACQUIRE, "agent");
            asm volatile("s_waitcnt vmcnt(0)" ::: "memory");
        }
    }
    __syncthreads();
}


__global__ void __launch_bounds__(NTH) mega(Params p_arg){
  cg::grid_group grid = cg::this_grid();
  KP kp = (KP)__builtin_amdgcn_kernarg_segment_ptr();
  volatile LAS unsigned* xst=(volatile LAS unsigned*)((LAS char*)smem+(LDS_BYTES-16));
  if (threadIdx.x==0){ xst[0]=0u; xst[1]=0u; }
  __syncthreads();
  XcdBarrier xb;
  { unsigned long long wsp=kp[28]; xb=xcd_barrier_post((unsigned*)((char*)wsp+OFF_BAR), xst); }
  int rep_a, rep_b;
  { unsigned long long rr=kp[29]; rep_a=(int)(rr&0xffffffffull); rep_b=(int)(rr>>32); }
  for (int r_=0;r_<((rep_b>>8)&255);++r_){ phase_prep(kp);
    if (rep_a==0x7fffffff) grid.sync();
    xcd_barrier(xb); }
  phase_h(kp);        xcd_barrier(xb);
  for (int r_=0;r_<(rep_b&255);++r_){ phase_gemm_dn(kp);  xcd_barrier(xb); }
  phase_dnprep(kp);   xcd_barrier(xb);
  if (gridDim.x>64){ if (blockIdx.x<32) phase_scan(kp); else phase_side(kp,blockIdx.x-32,gridDim.x-32); }
  else { phase_scan(kp); phase_side(kp,blockIdx.x,gridDim.x); }
  xcd_barrier(xb);
  phase_oa(kp);       xcd_barrier(xb);
  for (int hf=0; hf<2; ++hf){
    phase_gemm_hy(kp,hf); xcd_barrier(xb);
    phase_hyena(kp,hf);   xcd_barrier(xb);
  }
  phase_ybt(kp);    xcd_barrier(xb);
  phase_merge(kp);  xcd_barrier(xb);
  phase_out(kp);    xcd_barrier(xb);
  phase_final(kp);
}

extern "C" void kernel_launch(void* const* d_in, const int* in_sizes, int n_in,
                              void* d_out, int out_size, void* d_ws, size_t ws_size,
                              hipStream_t stream) {
  static int grid_blocks = 0;
  if (!grid_blocks) {
    int dev=0, cus=0, per_cu=0;
    hipGetDevice(&dev);
    hipDeviceGetAttribute(&cus, hipDeviceAttributeMultiprocessorCount, dev);
    hipFuncSetAttribute((const void*)mega, hipFuncAttributeMaxDynamicSharedMemorySize, LDS_BYTES);
    hipOccupancyMaxActiveBlocksPerMultiprocessor(&per_cu, (const void*)mega, NTH, LDS_BYTES);
    if (per_cu < 1) per_cu = 1;
    grid_blocks = cus * per_cu;
    if (grid_blocks > 256) grid_blocks = 256;
  }
  if (ws_size < WS_NEED) { fprintf(stderr, "workspace too small: %zu < %zu\n", ws_size, (size_t)WS_NEED); return; }
  Params p{};
  const float** pp = (const float**)&p;
  for (int i=0;i<27;++i) pp[i]=(const float*)d_in[i];
  p.out=(float*)d_out; p.ws=(char*)d_ws; p.rep_a=REP_A; p.rep_b=REP_B;
  hipMemsetAsync((char*)d_ws+OFF_BAR, 0, 16384, stream);
  void* args[] = {&p};
  hipError_t e = hipLaunchCooperativeKernel((const void*)mega, dim3(grid_blocks), dim3(NTH), args, LDS_BYTES, stream);
  if (e != hipSuccess) fprintf(stderr, "cooperative launch failed: %s (grid %d)\n", hipGetErrorString(e), grid_blocks);
}
```

```cpp
#include <hip/hip_runtime.h>
#include <hip/hip_bf16.h>
#include <hip/hip_cooperative_groups.h>
#include <cstdio>
namespace cg = cooperative_groups;

typedef unsigned short u16;
using bf16x8 = __attribute__((ext_vector_type(8))) short;
using f32x4 = __attribute__((ext_vector_type(4))) float;
typedef unsigned u32x4 __attribute__((ext_vector_type(4)));

#define NTH 512
#ifndef REP_A
#define REP_A 1
#endif
#ifndef REP_B
#define REP_B 0x101
#endif
#define EPSV 1e-6f
constexpr int LDS_BYTES = 131072 + 8192;

constexpr size_t SZ_WTIN = (size_t)10496 * 1024 * 2;
constexpr size_t SZ_HBUF = (size_t)16896 * 1024 * 2;
constexpr size_t OFF_WTIN = 0;
constexpr size_t OFF_HBUF = OFF_WTIN + SZ_WTIN;
constexpr size_t OFF_WTPA = OFF_HBUF + SZ_HBUF;
constexpr size_t OFF_WTPB = OFF_WTPA + 2097152;
constexpr size_t OFF_WTOUT= OFF_WTPB + 2097152;
constexpr size_t OFF_MOD  = OFF_WTOUT + 2097152;
constexpr size_t OFF_A3   = OFF_MOD + 36864;
constexpr size_t OFF_TW   = OFF_A3 + 2097152;
constexpr size_t OFF_GATES= OFF_TW + 131072;
constexpr size_t OFF_BAR  = OFF_GATES + (size_t)16896*32*4;
constexpr size_t OFF_R1C  = OFF_BAR + 16384;
constexpr size_t OFF_BIG  = OFF_R1C + (size_t)64*49152;
constexpr size_t TA_STRIDE= 25600;
constexpr size_t SZ_TA    = (size_t)16*132*TA_STRIDE;
constexpr size_t OFF_R1   = OFF_BIG;
constexpr size_t OFF_TAB  = OFF_R1 + (size_t)16896*3072*2;
constexpr size_t OFF_ZA   = OFF_TAB + SZ_TA;
constexpr size_t OFF_OA   = OFF_ZA;
constexpr size_t OFF_PHYT = OFF_BIG;
constexpr size_t OFF_YBT  = OFF_BIG + (size_t)2048*16384*2;
constexpr size_t OFF_YB   = OFF_BIG;
constexpr size_t OFF_FS   = OFF_YBT + (size_t)16384*1024*2;
constexpr size_t OFF_MA   = OFF_BIG + (size_t)16384*1024*2;
constexpr size_t OFF_M    = OFF_FS;
constexpr size_t WS_NEED  = OFF_ZA + (size_t)16384*1024*2;
static_assert(OFF_FS + (size_t)256*24576*8 <= OFF_ZA, "scratch overlaps oa");

struct Params {
  const float *x,*c,*ctx,*c_ctx,*w_mod,*b_mod,*norm_g,*w_in,*dn_conv_w,*dn_a_log,*dn_dt_bias,*dn_norm_g,
    *hy_conv_w,*hy_conv_b,*f_w1,*f_b1,*f_w2,*f_b2,*f_w3,*f_b3,*f_wout,*f_freq,*hy_bias,*w_pa,*w_pb,*w_out,*final_g;
  float* out;
  char* ws;
  int rep_a, rep_b;
};

extern __shared__ __attribute__((aligned(16))) char smem[];
typedef const __attribute__((address_space(4))) unsigned long long* KP;
__device__ __forceinline__ Params load_params(KP k){
  Params p; unsigned long long* d=(unsigned long long*)&p;
  _Pragma("unroll") for (int i=0;i<(int)(sizeof(Params)/8);++i) d[i]=k[i];
  return p; }

typedef float f32x2_t __attribute__((ext_vector_type(2)));
typedef __bf16 bf16x2_t __attribute__((ext_vector_type(2)));
__device__ __forceinline__ u16 f2bf(float f){ __bf16 h=(__bf16)f; return __builtin_bit_cast(u16,h); }
__device__ __forceinline__ float bf2f(u16 h){ return __uint_as_float(((unsigned)h)<<16); }
__device__ __forceinline__ unsigned pack2(float a, float b){ f32x2_t v={a,b}; bf16x2_t r=__builtin_convertvector(v,bf16x2_t); return __builtin_bit_cast(unsigned,r); }
__device__ __forceinline__ float siluf(float x){ return x/(1.f+__expf(-x)); }
__device__ __forceinline__ float sigmf(float x){ return 1.f/(1.f+__expf(-x)); }
__device__ __forceinline__ float wave_sum(float v){
  for (int o=32;o>=1;o>>=1) v += __shfl_xor(v,o);
  return v;
}

#define HD __device__ __forceinline__
HD float2 cmul(float2 a, float2 b){ return make_float2(a.x*b.x - a.y*b.y, a.x*b.y + a.y*b.x); }
HD float2 cmulc(float2 a, float2 b){ return make_float2(a.x*b.x + a.y*b.y, a.y*b.x - a.x*b.y); }
template<bool INV, bool NOTW>
HD void bf4c(float2* Z, int i0, int i1, int i2, int i3, float2 w1, float2 w2, float2 w3){
  float2 a0=Z[i0], a1=Z[i1], a2=Z[i2], a3=Z[i3];
  if (INV && !NOTW){ a1=cmulc(a1,w1); a2=cmulc(a2,w2); a3=cmulc(a3,w3); }
  float2 s02=make_float2(a0.x+a2.x,a0.y+a2.y), d02=make_float2(a0.x-a2.x,a0.y-a2.y);
  float2 s13=make_float2(a1.x+a3.x,a1.y+a3.y), d13=make_float2(a1.x-a3.x,a1.y-a3.y);
  float2 y0=make_float2(s02.x+s13.x,s02.y+s13.y), y2=make_float2(s02.x-s13.x,s02.y-s13.y);
  float2 ym=make_float2(d02.x+d13.y,d02.y-d13.x);
  float2 yp=make_float2(d02.x-d13.y,d02.y+d13.x);
  float2 y1, y3;
  if (INV){ y1=yp; y3=ym; } else if (NOTW){ y1=ym; y3=yp; } else { y1=cmul(ym,w1); y2=cmul(y2,w2); y3=cmul(yp,w3); }
  Z[i0]=y0; Z[i1]=y1; Z[i2]=y2; Z[i3]=y3;
}
HD int rev4_14(int p){ unsigned r = __brev((unsigned)p) >> 18; return (int)(((r & 0x2AAAu) >> 1) | ((r & 0x1555u) << 1)); }
template<bool INV, int LQ, bool BARRIER=true>
HD void fft_pass(float2* Z, const float2* twA, const float2* twB, int tid){
  constexpr int q=1<<LQ; constexpr int tws=4096>>LQ;
  if (LQ==12){
    _Pragma("unroll 2") for (int i=0;i<8;++i){ int t=tid+512*i; int k=t;
      float2 w1=cmul(twA[k>>6],twB[k&63]), w2=cmul(w1,w1), w3=cmul(w2,w1);
      bf4c<INV,false>(Z,t,t+q,t+2*q,t+3*q,w1,w2,w3); }
  } else if (LQ==10){
    _Pragma("unroll") for (int e=0;e<2;++e){ int j=tid+512*e; int k=j*tws;
      float2 w1=cmul(twA[k>>6],twB[k&63]), w2=cmul(w1,w1), w3=cmul(w2,w1);
      _Pragma("unroll") for (int ip=0;ip<4;++ip){ int base=ip*4096+j; bf4c<INV,false>(Z,base,base+q,base+2*q,base+3*q,w1,w2,w3); } }
  } else {
    int j=tid&(q-1); int base0=((tid>>LQ)<<(LQ+2))+j;
    float2 w1=make_float2(1.f,0.f), w2=w1, w3=w1;
    if (LQ>0){ int k=j*tws; w1=cmul(twA[k>>6],twB[k&63]); w2=cmul(w1,w1); w3=cmul(w2,w1); }
    _Pragma("unroll") for (int i=0;i<8;++i){ int base=base0+i*2048; bf4c<INV,(LQ==0)>(Z,base,base+q,base+2*q,base+3*q,w1,w2,w3); }
  }
  if (BARRIER) __syncthreads(); else asm volatile("s_waitcnt lgkmcnt(0)" ::: "memory");
}
__device__ __forceinline__ void fft_fwd_head(float2* Z, const float2* twA, const float2* twB, int tid){
  fft_pass<false,10>(Z,twA,twB,tid); fft_pass<false,8>(Z,twA,twB,tid); fft_pass<false,6,false>(Z,twA,twB,tid);
  fft_pass<false,4,false>(Z,twA,twB,tid); fft_pass<false,2,false>(Z,twA,twB,tid);
}
__device__ __forceinline__ void fft_inv_tail(float2* Z, const float2* twA, const float2* twB, int tid){
  fft_pass<true,2,false>(Z,twA,twB,tid); fft_pass<true,4,false>(Z,twA,twB,tid); fft_pass<true,6>(Z,twA,twB,tid);
  fft_pass<true,8>(Z,twA,twB,tid); fft_pass<true,10>(Z,twA,twB,tid);
}
HD void fwd12_padded(float2* Z, const float2* twA, const float2* twB, int t, float2 a0, float2 a1){
  float2 w1=cmul(twA[t>>6],twB[t&63]), w2=cmul(w1,w1), w3=cmul(w2,w1);
  Z[t]=make_float2(a0.x+a1.x,a0.y+a1.y);
  Z[t+4096]=cmul(make_float2(a0.x+a1.y,a0.y-a1.x),w1);
  Z[t+8192]=cmul(make_float2(a0.x-a1.x,a0.y-a1.y),w2);
  Z[t+12288]=cmul(make_float2(a0.x-a1.y,a0.y+a1.x),w3);
}
HD void inv12_half(const float2* Z, const float2* twA, const float2* twB, int t, float2& x0, float2& x1){
  float2 w1=cmul(twA[t>>6],twB[t&63]), w2=cmul(w1,w1), w3=cmul(w2,w1);
  float2 b0=Z[t], b1=cmulc(Z[t+4096],w1), b2=cmulc(Z[t+8192],w2), b3=cmulc(Z[t+12288],w3);
  float2 s02=make_float2(b0.x+b2.x,b0.y+b2.y), d02=make_float2(b0.x-b2.x,b0.y-b2.y);
  float2 s13=make_float2(b1.x+b3.x,b1.y+b3.y), d13=make_float2(b1.x-b3.x,b1.y-b3.y);
  x0=make_float2(s02.x+s13.x,s02.y+s13.y);
  x1=make_float2(d02.x-d13.y,d02.y+d13.x);
}
typedef _Float16 f16x2 __attribute__((ext_vector_type(2)));
__device__ __forceinline__ void fft_mid(float2* Z, const f16x2* Hp, int tid){
  _Pragma("unroll 4") for (int i=0;i<8;++i){ int base=(tid<<2)+i*2048;
    u32x4 hw=*(const u32x4*)(Hp+base);
    unsigned hw0=hw[0], hw1=hw[1], hw2=hw[2], hw3=hw[3];
    float2 a0=Z[base], a1=Z[base+1], a2=Z[base+2], a3=Z[base+3];
    float2 s02=make_float2(a0.x+a2.x,a0.y+a2.y), d02=make_float2(a0.x-a2.x,a0.y-a2.y);
    float2 s13=make_float2(a1.x+a3.x,a1.y+a3.y), d13=make_float2(a1.x-a3.x,a1.y-a3.y);
    float2 y0=make_float2(s02.x+s13.x,s02.y+s13.y), y2=make_float2(s02.x-s13.x,s02.y-s13.y);
    float2 y1=make_float2(d02.x+d13.y,d02.y-d13.x);
    float2 y3=make_float2(d02.x-d13.y,d02.y+d13.x);
    f16x2 h0=__builtin_bit_cast(f16x2,hw0), h1=__builtin_bit_cast(f16x2,hw1), h2=__builtin_bit_cast(f16x2,hw2), h3=__builtin_bit_cast(f16x2,hw3);
    float2 b0=cmul(y0,make_float2((float)h0[0],(float)h0[1])), b1=cmul(y1,make_float2((float)h1[0],(float)h1[1]));
    float2 b2=cmul(y2,make_float2((float)h2[0],(float)h2[1])), b3=cmul(y3,make_float2((float)h3[0],(float)h3[1]));
    float2 t02=make_float2(b0.x+b2.x,b0.y+b2.y), e02=make_float2(b0.x-b2.x,b0.y-b2.y);
    float2 t13=make_float2(b1.x+b3.x,b1.y+b3.y), e13=make_float2(b1.x-b3.x,b1.y-b3.y);
    Z[base]=make_float2(t02.x+t13.x,t02.y+t13.y); Z[base+2]=make_float2(t02.x-t13.x,t02.y-t13.y);
    Z[base+1]=make_float2(e02.x-e13.y,e02.y+e13.x);
    Z[base+3]=make_float2(e02.x+e13.y,e02.y-e13.x);
  }
  asm volatile("s_waitcnt lgkmcnt(0)" ::: "memory");
}

constexpr int BM=256, BK=64, HALF=128, HT=HALF*BK;
__device__ __forceinline__ int lds_byte(int r, int c) {
  int st=(r>>4)*2+(c>>5), rr=r&15, cc=c&31, ob=rr*64+cc*2;
  return st*1024 + (ob ^ (((ob>>9)&1)<<5));
}
__device__ __forceinline__ void stage_rc(int b, int&R, int&C) {
  int st=b/1024, sb=b%1024, swz=sb^(((sb>>9)&1)<<5);
  R=(st>>1)*16+swz/64; C=(st&1)*32+(swz%64)/2;
}
#define GK 1024
#define SA(b,h) (shm+((b)*2+(h))*HT)
#define SB(b,h) (shm+(4+(b)*2+(h))*HT)
#define STAGE(P,BASE,br,kt) do{const u16* _gb=(BASE)+((long)(br)*GK+(long)(kt)*BK); \
    __builtin_amdgcn_global_load_lds((const unsigned*)(_gb+soff0), \
      (__attribute__((address_space(3))) unsigned*)((__attribute__((address_space(3))) char*)(P)+gtid*16),16,0,0); \
    __builtin_amdgcn_global_load_lds((const unsigned*)(_gb+soff1), \
      (__attribute__((address_space(3))) unsigned*)((__attribute__((address_space(3))) char*)(P)+gtid*16+8192),16,0,0);}while(0)
#define LDA(dst,b,h) _Pragma("unroll") for(int m=0;m<4;++m) _Pragma("unroll") for(int k=0;k<2;++k) \
  dst[m][k]=*reinterpret_cast<const __attribute__((address_space(3))) bf16x8*>((__attribute__((address_space(3))) char*)SA(b,h)+lds_byte(wr*64+m*16+fr,k*32+fq*8))
#define LDB(dst,b,h) _Pragma("unroll") for(int n=0;n<2;++n) _Pragma("unroll") for(int k=0;k<2;++k) \
  dst[n][k]=*reinterpret_cast<const __attribute__((address_space(3))) bf16x8*>((__attribute__((address_space(3))) char*)SB(b,h)+lds_byte(wc*32+n*16+fr,k*32+fq*8))
#define MMA(ai,bj,At,Bt_) do{__builtin_amdgcn_s_setprio(1); \
  _Pragma("unroll") for(int m=0;m<4;++m) _Pragma("unroll") for(int n=0;n<2;++n) _Pragma("unroll") for(int k=0;k<2;++k) \
    acc[ai][bj][m][n]=__builtin_amdgcn_mfma_f32_16x16x32_bf16(At[m][k],Bt_[n][k],acc[ai][bj][m][n],0,0,0); \
  __builtin_amdgcn_s_setprio(0);}while(0)
#define WAIT_V(n) asm volatile("s_waitcnt vmcnt(" #n ")":::"memory")
#define WAIT_L(n) asm volatile("s_waitcnt lgkmcnt(" #n ")":::"memory")
#define BAR __builtin_amdgcn_s_barrier()
#define SCHED __builtin_amdgcn_sched_barrier(0)

__device__ __forceinline__ void gemm_core(const u16* __restrict__ A, const u16* __restrict__ Bt, int brow, int bcol,
                                          f32x4 (&acc)[2][2][4][2]) {
  __attribute__((address_space(3))) u16* shm = (__attribute__((address_space(3))) u16*)smem;
  int gtid=threadIdx.x; asm volatile("" : "+v"(gtid));
  int wid=gtid>>6,lane=gtid&63,wr=wid>>2,wc=wid&3,fr=lane&15,fq=lane>>4;
  _Pragma("unroll") for(int a=0;a<2;++a) _Pragma("unroll") for(int b=0;b<2;++b) _Pragma("unroll") for(int m=0;m<4;++m) _Pragma("unroll") for(int n=0;n<2;++n) acc[a][b][m][n]=f32x4{0.f,0.f,0.f,0.f};
  bf16x8 At[4][2],B0[2][2],B1[2][2];
  int soff0, soff1; { int _r,_c; stage_rc(gtid*16,_r,_c); soff0=_r*GK+_c; stage_rc(gtid*16+8192,_r,_c); soff1=_r*GK+_c; }
  constexpr int nt=GK/BK;
  STAGE(SB(0,0),Bt,bcol,0); STAGE(SA(0,0),A,brow,0);
  STAGE(SB(0,1),Bt,bcol+HALF,0); STAGE(SA(0,1),A,brow+HALF,0);
  if(wr==1)BAR;
  WAIT_V(4); BAR;
  STAGE(SB(1,0),Bt,bcol,1); STAGE(SA(1,0),A,brow,1); STAGE(SB(1,1),Bt,bcol+HALF,1);
  WAIT_V(6); BAR;
  for(int t=0;t<nt-2;t+=2){
    LDB(B0,0,0); SCHED; LDA(At,0,0); STAGE(SA(1,1),A,brow+HALF,t+1);
    WAIT_L(8); BAR; WAIT_L(0); MMA(0,0,At,B0); BAR; SCHED;
    LDB(B1,0,1); STAGE(SB(0,0),Bt,bcol,t+2);
    BAR; WAIT_L(0); MMA(0,1,At,B1); BAR;
    LDA(At,0,1); STAGE(SA(0,0),A,brow,t+2);
    BAR; WAIT_L(0); MMA(1,0,At,B0); BAR; SCHED;
    STAGE(SB(0,1),Bt,bcol+HALF,t+2);
    WAIT_V(6); BAR; MMA(1,1,At,B1); BAR;
    LDB(B0,1,0); SCHED; LDA(At,1,0); STAGE(SA(0,1),A,brow+HALF,t+2);
    WAIT_L(8); BAR; WAIT_L(0); MMA(0,0,At,B0); BAR; SCHED;
    LDB(B1,1,1); STAGE(SB(1,0),Bt,bcol,t+3);
    BAR; WAIT_L(0); MMA(0,1,At,B1); BAR;
    LDA(At,1,1); STAGE(SA(1,0),A,brow,t+3);
    BAR; WAIT_L(0); MMA(1,0,At,B0); BAR; SCHED;
    STAGE(SB(1,1),Bt,bcol+HALF,t+3);
    WAIT_V(6); BAR; MMA(1,1,At,B1); BAR;
  }
  { LDB(B0,0,0); LDA(At,0,0); STAGE(SA(1,1),A,brow+HALF,nt-1);
    BAR; WAIT_L(0); MMA(0,0,At,B0); BAR;
    LDB(B1,0,1); BAR; WAIT_L(0); MMA(0,1,At,B1); BAR;
    LDA(At,0,1); WAIT_V(4); BAR; WAIT_L(0); MMA(1,0,At,B0); MMA(1,1,At,B1); BAR; }
  { LDB(B0,1,0); LDA(At,1,0); WAIT_V(2); BAR; WAIT_L(0); MMA(0,0,At,B0); BAR;
    LDB(B1,1,1); WAIT_V(0); BAR; WAIT_L(0); MMA(0,1,At,B1); BAR;
    LDA(At,1,1); BAR; WAIT_L(0); MMA(1,0,At,B0); MMA(1,1,At,B1); BAR; }
  if(wr==0)BAR;
  SCHED;
}
#define EPI_BEGIN { int _t=threadIdx.x; asm volatile("" : "+v"(_t)); int _wid=_t>>6,_lane=_t&63,_wr=_wid>>2,_wc=_wid&3,_fr=_lane&15,_fq=_lane>>4; \
  _Pragma("unroll") for(int ai=0;ai<2;++ai) _Pragma("unroll") for(int bj=0;bj<2;++bj) _Pragma("unroll") for(int m=0;m<4;++m) _Pragma("unroll") for(int n=0;n<2;++n){ \
    int R0=ai*HALF+_wr*64+m*16+_fq*4, C0=bj*HALF+_wc*32+n*16+_fr; f32x4 v=acc[ai][bj][m][n]; (void)R0; (void)C0;
#define EPI_END asm volatile("":::"memory"); }}
#define EPIG_BEGIN { int _t=threadIdx.x; asm volatile("" : "+v"(_t)); int _wid=_t>>6,_lane=_t&63,_wr=_wid>>2,_wc=_wid&3,_fr=_lane&15,_fq=_lane>>4; \
  _Pragma("unroll") for(int ai=0;ai<2;++ai) _Pragma("unroll") for(int bj=0;bj<2;++bj){
#define EPIG_FOR _Pragma("unroll") for(int m=0;m<4;++m) _Pragma("unroll") for(int n=0;n<2;++n){ const int idx=m*2+n; int R0=ai*HALF+_wr*64+m*16+_fq*4, C0=bj*HALF+_wc*32+n*16+_fr; (void)idx; (void)R0; (void)C0;
#define EPIG_ENDFOR }
#define EPIG_END asm volatile("":::"memory"); }}

__device__ __forceinline__ int wperm(int np){ return np<4096 ? np : (np<10240 ? np+32 : (np<10272 ? 4096+(np-10240) : -1)); }
__device__ __forceinline__ void transpose_tile(const float* __restrict__ src, int ld_src, int kind, u16* __restrict__ dst, int n0, int k0, int tid){
  float* tile = (float*)smem;
  _Pragma("unroll") for (int i=0;i<2;++i){ int e=tid+512*i; int kk=e>>4, n4=(e&15)*4; int np=n0+n4;
    float4 v=make_float4(0.f,0.f,0.f,0.f);
    if (kind==0){ int ns=wperm(np);
      if (ns>=0) v=*(const float4*)(src+(size_t)(k0+kk)*ld_src+ns); }
    else v=*(const float4*)(src+(size_t)(k0+kk)*ld_src+np);
    *(float4*)(tile+kk*68+n4)=v; }
  __syncthreads();
  { int nn=tid>>3, k8=(tid&7)*8;
    u32x4 pk;
    pk[0]=pack2(tile[(k8+0)*68+nn],tile[(k8+1)*68+nn]); pk[1]=pack2(tile[(k8+2)*68+nn],tile[(k8+3)*68+nn]);
    pk[2]=pack2(tile[(k8+4)*68+nn],tile[(k8+5)*68+nn]); pk[3]=pack2(tile[(k8+6)*68+nn],tile[(k8+7)*68+nn]);
    *(u32x4*)(dst+(size_t)(n0+nn)*1024+k0+k8)=pk; }
  __syncthreads();
}

__device__ __forceinline__ void phase_prep(KP kp_){ asm volatile("" : "+s"(kp_)); const Params p=load_params(kp_);
  int ftid=threadIdx.x; asm volatile("" : "+v"(ftid));
  int tid=ftid, lane=tid&63, wid=tid>>6;
  char* ws=p.ws;
  for (int it=blockIdx.x; it<2624; it+=gridDim.x){
    { int nt_=it>>4, kt=it&15; transpose_tile(p.w_in,10272,0,(u16*)(ws+OFF_WTIN),nt_*64,kt*64,tid); }
    if (false) { int j=it-2624; int w=j>>8; int r=j&255; int nt_=r>>4, kt=r&15;
      const float* src = w==0?p.w_pa:(w==1?p.w_pb:p.w_out); size_t off = w==0?OFF_WTPA:(w==1?OFF_WTPB:OFF_WTOUT);
      transpose_tile(src,1024,1,(u16*)(ws+off),nt_*64,kt*64,tid); }
  }
  float* modv=(float*)(ws+OFF_MOD);
  for (int it=blockIdx.x; it<256; it+=gridDim.x){
    float acc[3][12];
    for(int a=0;a<3;++a)for(int j=0;j<12;++j)acc[a][j]=0.f;
    for (int r=0;r<2;++r){ int k=tid+512*r;
      float s0=siluf(p.c[k]), s1=siluf(p.c[1024+k]), s2=siluf(p.c_ctx[k]);
      const float4* wp=(const float4*)(p.w_mod+(size_t)k*3072+it*12);
      for(int q=0;q<3;++q){ float4 w=wp[q];
        acc[0][q*4+0]+=s0*w.x; acc[0][q*4+1]+=s0*w.y; acc[0][q*4+2]+=s0*w.z; acc[0][q*4+3]+=s0*w.w;
        acc[1][q*4+0]+=s1*w.x; acc[1][q*4+1]+=s1*w.y; acc[1][q*4+2]+=s1*w.z; acc[1][q*4+3]+=s1*w.w;
        acc[2][q*4+0]+=s2*w.x; acc[2][q*4+1]+=s2*w.y; acc[2][q*4+2]+=s2*w.z; acc[2][q*4+3]+=s2*w.w; } }
    float* red=(float*)smem;
    for(int a=0;a<3;++a)for(int j=0;j<12;++j){ float v=wave_sum(acc[a][j]); if(lane==0) red[wid*36+a*12+j]=v; }
    __syncthreads();
    if (tid<36){ float s=0; for(int w=0;w<8;++w)s+=red[w*36+tid]; int a=tid/12,j=tid%12; modv[a*3072+it*12+j]=s+p.b_mod[it*12+j]; }
    __syncthreads();
  }
}
__device__ __forceinline__ void phase_side(KP kp_, int bid, int nb){ asm volatile("" : "+s"(kp_)); const Params p=load_params(kp_);
  int ftid=threadIdx.x; asm volatile("" : "+v"(ftid));
  int tid=ftid, lane=tid&63, wid=tid>>6;
  char* ws=p.ws;
  for (int j=bid; j<768; j+=nb){ int w=j>>8; int r=j&255; int nt_=r>>4, kt=r&15;
    const float* src = w==0?p.w_pa:(w==1?p.w_pb:p.w_out); size_t off = w==0?OFF_WTPA:(w==1?OFF_WTPB:OFF_WTOUT);
    transpose_tile(src,1024,1,(u16*)(ws+off),nt_*64,kt*64,tid); }
  _Float16* a3=(_Float16*)(ws+OFF_A3);
  for (int t=bid*8+wid; t<8192; t+=nb*8){
    float pe=0.f;
    if (lane==0) pe=(float)t/8191.f;
    else if (lane<33){ int bi=(lane-1)&15; float s=(float)bi/15.f; float fb=1e-4f*(1.f-s)+15.f*s; float wpos=(float)(6.283185307179586/8192.0)*(float)t; float arg=fb*wpos;
      pe = lane<17 ? cosf(arg) : -sinf(arg); }
    float fr_=p.f_freq[lane];
    float acc=p.f_b1[lane];
    for(int i=0;i<33;++i) acc += __shfl(pe,i)*p.f_w1[i*64+lane];
    float a1=sinf(fr_*acc);
    acc=p.f_b2[lane];
    for(int i=0;i<64;++i) acc += __shfl(a1,i)*p.f_w2[i*64+lane];
    float a2=sinf(fr_*acc);
    acc=p.f_b3[lane];
    for(int i=0;i<64;++i) acc += __shfl(a2,i)*p.f_w3[i*64+lane];
    a3[t*64+lane]=(_Float16)sinf(fr_*acc);
  }
  float2* tw=(float2*)(ws+OFF_TW);
  for (int k=bid*512+tid; k<16384; k+=nb*512){
    float s,c; sincospif((float)k/8192.f,&s,&c); tw[k]=make_float2(c,-s); }
}

__device__ __forceinline__ void phase_h(KP kp_){ asm volatile("" : "+s"(kp_)); const Params p=load_params(kp_);
  int ftid=threadIdx.x; asm volatile("" : "+v"(ftid));
  int lane=ftid&63, wid=ftid>>6;
  const float* modv=(const float*)(p.ws+OFF_MOD);
  u16* hbuf=(u16*)(p.ws+OFF_HBUF);
  for (int r=blockIdx.x*8+wid; r<16896; r+=gridDim.x*8){
    const float* src = r<16384 ? p.x+(size_t)r*1024 : p.ctx+(size_t)(r-16384)*1024;
    int v = r<16384 ? (r>>13) : 2;
    float4 xv[4]; float ss=0.f;
    for(int i=0;i<4;++i){ xv[i]=*(const float4*)(src+lane*4+256*i); ss+=xv[i].x*xv[i].x+xv[i].y*xv[i].y+xv[i].z*xv[i].z+xv[i].w*xv[i].w; }
    ss=wave_sum(ss); float rstd=rsqrtf(ss*(1.f/1024.f)+EPSV);
    for(int i=0;i<4;++i){ int col=lane*4+256*i;
      float4 g=*(const float4*)(p.norm_g+col); float4 sh=*(const float4*)(modv+v*3072+col); float4 sc=*(const float4*)(modv+v*3072+1024+col);
      float h0=xv[i].x*rstd*g.x*(1.f+sc.x)+sh.x, h1=xv[i].y*rstd*g.y*(1.f+sc.y)+sh.y, h2=xv[i].z*rstd*g.z*(1.f+sc.z)+sh.z, h3=xv[i].w*rstd*g.w*(1.f+sc.w)+sh.w;
      uint2 pk; pk.x=pack2(h0,h1); pk.y=pack2(h2,h3);
      *(uint2*)(hbuf+(size_t)r*1024+col)=pk; }
  }
}

__device__ __forceinline__ void phase_gemm_hy(KP kp_, int hf){ asm volatile("" : "+s"(kp_)); const Params p=load_params(kp_);
  const u16* hbuf=(const u16*)(p.ws+OFF_HBUF); const u16* wt=(const u16*)(p.ws+OFF_WTIN); u16* phyT=(u16*)(p.ws+OFF_PHYT); u16* PG=(u16*)p.out;
  int ntile = hf==0 ? 1024 : 512;
  for (int it=blockIdx.x; it<ntile; it+=gridDim.x){
    f32x4 acc[2][2][4][2];
    if (it<512){
      int q8=it&7, rt=it>>3; int g=q8>>1, tt=q8&1; int ct=16+g*4+hf*2+tt;
      gemm_core(hbuf, wt, rt*256, ct*256, acc);
      EPI_BEGIN
        int tok=rt*256+R0; int prow=g*512+tt*256+C0;
        if (g==3){ v[0]=siluf(v[0]); v[1]=siluf(v[1]); v[2]=siluf(v[2]); v[3]=siluf(v[3]); }
        uint2 pk; pk.x=pack2(v[0],v[1]); pk.y=pack2(v[2],v[3]);
        *(uint2*)(phyT+(size_t)prow*16384+tok)=pk;
      EPI_END
    } else {
      int j=it-512; int ct=32+(j&7), rt=j>>3;
      gemm_core(wt, hbuf, ct*256, rt*256, acc);
      EPI_BEGIN
        int np=ct*256+R0; int tok=rt*256+C0;
        uint2 pk; pk.x=pack2(sigmf(v[0]),sigmf(v[1])); pk.y=pack2(sigmf(v[2]),sigmf(v[3])); *(uint2*)(PG+(size_t)tok*2048+(np-8192))=pk;
      EPI_END
    }
  }
}

__device__ __forceinline__ float hconv3(const u16* __restrict__ row, int t, float w0, float w1, float w2, float bias){
  float m = bf2f(row[t]);
  int mi=__float_as_int(m);
  float l=__int_as_float(__builtin_amdgcn_update_dpp(0, mi, 0x138, 0xf, 0xf, false));
  float r=__int_as_float(__builtin_amdgcn_update_dpp(0, mi, 0x130, 0xf, 0xf, false));
  return w0*l+w1*m+w2*r+bias;
}
typedef _Float16 f16x8 __attribute__((ext_vector_type(8)));
__device__ __forceinline__ float2 ld_h2_coherent(const f16x2* ptr){
  unsigned u = __hip_atomic_load((const unsigned*)ptr, __ATOMIC_RELAXED, __HIP_MEMORY_SCOPE_AGENT);
  f16x2 h=__builtin_bit_cast(f16x2,u); return make_float2((float)h[0],(float)h[1]);
}
__device__ __forceinline__ void phase_hyena(KP kp_, int hf){ asm volatile("" : "+s"(kp_)); const Params p=load_params(kp_);
  int ftid=threadIdx.x; asm volatile("" : "+v"(ftid));
  int tid=ftid, lane=tid&63, wid=tid>>6;
  float2* Z=(float2*)smem; float* misc=(float*)(smem+131072);
  float2* twA=(float2*)(misc+512); float2* twB=(float2*)(misc+640);
  const float2* tw=(const float2*)(p.ws+OFF_TW);
  const _Float16* a3=(const _Float16*)(p.ws+OFF_A3);
  const u16* phyT=(const u16*)(p.ws+OFF_PHYT);
  u16* ybT=(u16*)(p.ws+OFF_YBT);
  char* scr=p.ws+OFF_FS+(size_t)blockIdx.x*196608;
  f16x2* H0p=(f16x2*)scr; f16x2* H1p=H0p+16384; float2* Zs=(float2*)(scr+131072);
  if (tid<64) twA[tid]=tw[tid*64]; else if (tid<128) twB[tid-64]=tw[tid-64];
  for (int cl=blockIdx.x; cl<512; cl+=gridDim.x){ int c=hf*512+cl;
    asm volatile("" : "+v"(tid)); lane=tid&63; wid=tid>>6;
    __syncthreads();
    if (tid<256){ int i=tid>>2, so=tid&3; misc[tid]=p.f_wout[(size_t)i*4096+(so>>1)*2048+(so&1)*1024+c]; }
    __syncthreads();
    const float lo=-3.0701134573253945f, hi=-15.350567286626973f;
    float sfrac=(float)c/1023.f;
    float delta=fabsf(lo*(1.f-sfrac)+hi*sfrac);
    const u16* rv=phyT+(size_t)cl*16384; const u16* r1=phyT+(size_t)(512+cl)*16384; const u16* r2=phyT+(size_t)(1024+cl)*16384; const u16* rz=phyT+(size_t)(1536+cl)*16384;
    float wv0=p.hy_conv_w[c], wv1=p.hy_conv_w[3072+c], wv2=p.hy_conv_w[6144+c], bv_=p.hy_conv_b[c];
    float wa0=p.hy_conv_w[1024+c], wa1=p.hy_conv_w[3072+1024+c], wa2=p.hy_conv_w[6144+1024+c], ba_=p.hy_conv_b[1024+c];
    float wb0=p.hy_conv_w[2048+c], wb1=p.hy_conv_w[3072+2048+c], wb2=p.hy_conv_w[6144+2048+c], bb_=p.hy_conv_b[2048+c];
    float bias0=p.hy_bias[c], bias1=p.hy_bias[1024+c];
    float nrm0=1.f, nrm1=1.f;
    _Pragma("unroll 1") for (int st=0; st<3; ++st){
      if (st==0){
    float ss0=0.f, ss1=0.f;
    {
      int n=lane&15, kg=lane>>4;
      f16x8 bw0, bw1;
      _Pragma("unroll") for (int e=0;e<8;++e){ bw0[e]=(n<4)?(_Float16)misc[(kg*8+e)*4+n]:(_Float16)0.f; bw1[e]=(n<4)?(_Float16)misc[(32+kg*8+e)*4+n]:(_Float16)0.f; }
      const float dsc=-delta*(1.f/8191.f);
      float pj0=__expf(dsc*(float)(kg*4)), pj1=__expf(dsc*(float)(kg*4+1)), pj2=__expf(dsc*(float)(kg*4+2)), pj3=__expf(dsc*(float)(kg*4+3));
      float* Zf=(float*)Z; float ssl=0.f; int order=n&1; bool side1=(n&2)!=0;
      _Pragma("unroll 8") for (int i=0;i<64;++i){ int tl=wid+8*i;
        const _Float16* ap=a3+(size_t)(tl*16+n)*64+kg*8;
        f16x8 a0=*(const f16x8*)ap, a1=*(const f16x8*)(ap+32);
        f32x4 dd={0.f,0.f,0.f,0.f};
        dd=__builtin_amdgcn_mfma_f32_16x16x32_f16(a0,bw0,dd,0,0,0);
        dd=__builtin_amdgcn_mfma_f32_16x16x32_f16(a1,bw1,dd,0,0,0);
        if (n<4){ float d0=__expf(dsc*(float)(tl*16)); int lag0=tl*16+kg*4;
          float v0=dd[0]*d0*pj0, v1=dd[1]*d0*pj1, v2=dd[2]*d0*pj2, v3=dd[3]*d0*pj3;
          if (!side1){ Zf[2*(lag0)+order]=v0; Zf[2*(lag0+1)+order]=v1; Zf[2*(lag0+2)+order]=v2; Zf[2*(lag0+3)+order]=v3; ssl+=v0*v0+v1*v1+v2*v2+v3*v3; }
          else { if (lag0>=1){ Zf[2*(16384-lag0)+order]=v0; ssl+=v0*v0; }
            Zf[2*(16384-lag0-1)+order]=v1; Zf[2*(16384-lag0-2)+order]=v2; Zf[2*(16384-lag0-3)+order]=v3; ssl+=v1*v1+v2*v2+v3*v3; } }
      }
      ss0=(n<4 && order==0)?ssl:0.f; ss1=(n<4 && order==1)?ssl:0.f;
    }
    if (tid==0) Z[8192]=make_float2(0.f,0.f);
    ss0=wave_sum(ss0); ss1=wave_sum(ss1);
    if (lane==0){ misc[256+wid*2]=ss0; misc[256+wid*2+1]=ss1; }
    __syncthreads();
    float t0=0.f,t1=0.f; for(int w=0;w<8;++w){ t0+=misc[256+w*2]; t1+=misc[256+w*2+1]; }
    nrm0=rsqrtf(t0+EPSV); nrm1=rsqrtf(t1+EPSV);
      }
      __syncthreads();
      if (st==0){ fft_pass<false,12>(Z,twA,twB,tid); }
      else if (st==1){ int tq=tid; asm volatile("" : "+v"(tq));
        _Pragma("unroll 4") for (int i=0;i<8;++i){ int t=tq+512*i;
          float2 a0=make_float2(hconv3(rv,t,wv0,wv1,wv2,bv_), hconv3(rv+8192,t,wv0,wv1,wv2,bv_));
          float2 a1=make_float2(hconv3(rv,t+4096,wv0,wv1,wv2,bv_), hconv3(rv+8192,t+4096,wv0,wv1,wv2,bv_));
          fwd12_padded(Z,twA,twB,t,a0,a1); }
        __syncthreads();
      } else { int tq=tid; asm volatile("" : "+v"(tq));
        _Pragma("unroll 4") for (int i=0;i<8;++i){ int t=tq+512*i; fwd12_padded(Z,twA,twB,t,Zs[t],Zs[t+4096]); }
        __syncthreads();
      }
      fft_fwd_head(Z,twA,twB,tid);
      if (st==0){
        fft_pass<false,0>(Z,twA,twB,tid);
    _Pragma("unroll 2") for (int i=0;i<8;++i){ int q0=(tid+512*i)*4; u32x4 h0w, h1w;
      _Pragma("unroll") for (int m=0;m<4;++m){ int q=q0+m; int k=rev4_14(q);
        float2 Fk=Z[q], Fn=Z[rev4_14((16384-k)&16383)];
        f16x2 h0v={(_Float16)(0.5f*nrm0*(Fk.x+Fn.x)),(_Float16)(0.5f*nrm0*(Fk.y-Fn.y))};
        f16x2 h1v={(_Float16)(0.5f*nrm1*(Fk.y+Fn.y)),(_Float16)(-0.5f*nrm1*(Fk.x-Fn.x))};
        unsigned u0=__builtin_bit_cast(unsigned,h0v), u1=__builtin_bit_cast(unsigned,h1v);
        h0w[m]=u0; h1w[m]=u1; }
      *(u32x4*)(H0p+q0)=h0w; *(u32x4*)(H1p+q0)=h1w; }
        __builtin_amdgcn_fence(__ATOMIC_ACQUIRE, "agent");
      } else {
        const f16x2* Hp = st==1 ? H0p : H1p;
        fft_mid(Z,Hp,tid);
        fft_inv_tail(Z,twA,twB,tid);
        if (st==1){ int tq=tid; asm volatile("" : "+v"(tq));
          _Pragma("unroll 4") for (int i=0;i<8;++i){ int tb=tq+512*i; float2 xr[2]; inv12_half(Z,twA,twB,tb,xr[0],xr[1]);
            _Pragma("unroll") for (int hh=0;hh<2;++hh){ int t=tb+hh*4096;
              float u0=hconv3(rv,t,wv0,wv1,wv2,bv_), u1=hconv3(rv+8192,t,wv0,wv1,wv2,bv_);
              float x0=hconv3(r1,t,wa0,wa1,wa2,ba_), x1=hconv3(r1+8192,t,wa0,wa1,wa2,ba_);
              float2 y=xr[hh]; y.x*=(1.f/16384.f); y.y*=(1.f/16384.f);
              Zs[t]=make_float2(x0*(y.x+u0*bias0), x1*(y.y+u1*bias0)); } }
        } else { int tq=tid; asm volatile("" : "+v"(tq));
          _Pragma("unroll 4") for (int i=0;i<8;++i){ int tb=tq+512*i; float2 xr[2]; inv12_half(Z,twA,twB,tb,xr[0],xr[1]);
            _Pragma("unroll") for (int hh=0;hh<2;++hh){ int t=tb+hh*4096;
              float x0=hconv3(r2,t,wb0,wb1,wb2,bb_), x1=hconv3(r2+8192,t,wb0,wb1,wb2,bb_);
              float2 y=xr[hh]; y.x*=(1.f/16384.f); y.y*=(1.f/16384.f); float2 z1=Zs[t];
              float o0=x0*(y.x+z1.x*bias1)*bf2f(rz[t]); float o1=x1*(y.y+z1.y*bias1)*bf2f(rz[8192+t]);
              ybT[(size_t)c*16384+t]=f2bf(o0); ybT[(size_t)c*16384+8192+t]=f2bf(o1); } }
        }
      }
      __syncthreads();
    }
  }
}

__device__ __forceinline__ void phase_ybt(KP kp_){ asm volatile("" : "+s"(kp_)); const Params p=load_params(kp_);
  int tid=threadIdx.x; asm volatile("" : "+v"(tid));
  const u16* ybT=(const u16*)(p.ws+OFF_YBT); u16* yb=(u16*)(p.ws+OFF_YB);
  u16* tile=(u16*)smem;
  for (int it=blockIdx.x; it<4096; it+=gridDim.x){
    int c0=(it&15)*64, t0=(it>>4)*64;
    __syncthreads();
    { int ch=tid>>3, t8=(tid&7)*8; *(u32x4*)(tile+ch*72+t8)=*(const u32x4*)(ybT+(size_t)(c0+ch)*16384+t0+t8); }
    __syncthreads();
    { int tk=tid>>3, c8=(tid&7)*8; u32x4 pk;
      _Pragma("unroll") for (int q=0;q<4;++q) pk[q]=(unsigned)tile[(c8+2*q)*72+tk] | ((unsigned)tile[(c8+2*q+1)*72+tk]<<16);
      *(u32x4*)(yb+(size_t)(t0+tk)*1024+c0+c8)=pk; }
  }
}

__device__ __forceinline__ void phase_gemm_dn(KP kp_){ asm volatile("" : "+s"(kp_)); const Params p=load_params(kp_);
  const u16* hbuf=(const u16*)(p.ws+OFF_HBUF); const u16* wt=(const u16*)(p.ws+OFF_WTIN);
  u16* R1=(u16*)(p.ws+OFF_R1); u16* ZA=(u16*)(p.ws+OFF_ZA); float* gates=(float*)(p.ws+OFF_GATES);
  for (int it=blockIdx.x; it<1056+66; it+=gridDim.x){
    int ct, rt;
    if (it<1056){ ct=it&15; rt=it>>4; } else { ct=40; rt=it-1056; }
    f32x4 acc[2][2][4][2];
    gemm_core(wt, hbuf, ct*256, rt*256, acc);
    EPI_BEGIN
      int np=ct*256+R0; int tok=rt*256+C0;
      if (ct<12){ uint2 pk; pk.x=pack2(v[0],v[1]); pk.y=pack2(v[2],v[3]); *(uint2*)(R1+(size_t)tok*3072+np)=pk; }
      else if (ct<16){ if (tok<16384){ uint2 pk; pk.x=pack2(siluf(v[0]),siluf(v[1])); pk.y=pack2(siluf(v[2]),siluf(v[3])); *(uint2*)(ZA+(size_t)tok*1024+(np-3072))=pk; } }
      else { int g=np-10240; if (g<32){ *(float4*)(gates+(size_t)tok*32+g)=make_float4(v[0],v[1],v[2],v[3]); } }
    EPI_END
  }
}

__device__ __forceinline__ void slot_bases(char* ws, int b, int cidx, int h, char*& bq, char*& bk, char*& bv, int& stride){
  if (cidx>=4){ int n=cidx-4; size_t tok0=(size_t)b*8192+n*64; char* base=ws+OFF_R1+tok0*6144+(size_t)h*256; bq=base; bk=base+2048; bv=base+4096; stride=6144; }
  else { char* base=ws+OFF_R1C+(size_t)((b*4+cidx)*8+h)*49152; bq=base; bk=base+16384; bv=base+32768; stride=256; }
}
__device__ __forceinline__ void phase_dnprep(KP kp_){ asm volatile("" : "+s"(kp_)); const Params p=load_params(kp_);
  float* raw=(float*)smem;
  float* tmp=(float*)(smem+34816);
  char* qs=smem+67584;
  char* ks=smem+84992;
  float* Lf=(float*)(smem+102400);
  float* Lb=(float*)(smem+118784);
  float* sm=(float*)(smem+135168);
  float *gcf=sm, *gcb=sm+64, *bef=sm+128, *beb=sm+192, *scl=sm+256;
  const u16* R1=(const u16*)(p.ws+OFF_R1); const float* gates=(const float*)(p.ws+OFF_GATES);
  u32x4 rp0,rp1,rp2; bool have_raw=false;
  for (int item=blockIdx.x; item<2112; item+=gridDim.x){
    int tid=threadIdx.x; asm volatile("" : "+v"(tid)); int lane=tid&63, wid=tid>>6;
    int b,n,h,cidx,tok0,rs,re;
    if (item<2048){ b=item>>10; n=(item>>3)&127; h=item&7; cidx=n+4; tok0=b*8192+n*64; rs=tok0; re=tok0+64; }
    else { int j=item-2048; b=j>>5; n=(j>>3)&3; h=j&7; cidx=n; tok0=16384+b*256+n*64; rs=16384+b*256; re=rs+256; }
    char *bq,*bk,*bv; int stride; slot_bases(p.ws,b,cidx,h,bq,bk,bv,stride);
    size_t ia=(size_t)((b*8+h)*132+cidx)*TA_STRIDE;
    char* taf=(char*)p.out+ia; char* tab=p.ws+OFF_TAB+ia;
    __syncthreads();
    if (wid==0){ const float* gr=gates+(size_t)(tok0+lane)*32;
      float bf_=1.f/(1.f+expf(-gr[h])), bb_=1.f/(1.f+expf(-gr[8+h]));
      float xf=gr[16+h]+p.dn_dt_bias[h], xb=gr[24+h]+p.dn_dt_bias[8+h];
      float spf=xf>20.f?xf:log1pf(expf(xf)), spb=xb>20.f?xb:log1pf(expf(xb));
      float gf=-expf(p.dn_a_log[h])*spf, gb=-expf(p.dn_a_log[8+h])*spb;
      for (int o=1;o<64;o<<=1){ float t=__shfl_up(gf,o); if (lane>=o) gf+=t; float u=__shfl_down(gb,o); if (lane+o<64) gb+=u; }
      gcf[lane]=gf; gcb[lane]=gb; bef[lane]=bf_; beb[lane]=bb_;
      *(float*)(taf+24576+lane*4)=gf; *(float*)(tab+24576+lane*4)=gb; }
#define RAWLOAD_AT(w_,tok0,rs,re,h) { const u16* rb=R1+(size_t)(w_)*1024+(h)*128; \
      { int e=tid; int i=e>>4, c8=(e&15)*8; int tk=tok0-2+i; rp0=u32x4{0,0,0,0}; if (tk>=rs && tk<re) rp0=*(const u32x4*)(rb+(size_t)tk*3072+c8); } \
      { int e=tid+512; int i=e>>4, c8=(e&15)*8; int tk=tok0-2+i; rp1=u32x4{0,0,0,0}; if (tk>=rs && tk<re) rp1=*(const u32x4*)(rb+(size_t)tk*3072+c8); } \
      { int e=tid+1024; int i=e>>4, c8=(e&15)*8; int tk=tok0-2+i; rp2=u32x4{0,0,0,0}; if (e<1088 && tk>=rs && tk<re) rp2=*(const u32x4*)(rb+(size_t)tk*3072+c8); } }
#define RAWPUT1(rp_,e_) { int e=(e_); if (e<1088){ int i=e>>4, c8=(e&15)*8; float* d=raw+i*128+c8; \
      d[0]=__uint_as_float(rp_[0]<<16); d[1]=__uint_as_float(rp_[0]&0xffff0000u); d[2]=__uint_as_float(rp_[1]<<16); d[3]=__uint_as_float(rp_[1]&0xffff0000u); \
      d[4]=__uint_as_float(rp_[2]<<16); d[5]=__uint_as_float(rp_[2]&0xffff0000u); d[6]=__uint_as_float(rp_[3]<<16); d[7]=__uint_as_float(rp_[3]&0xffff0000u); } }
#define RAWLOAD(w_) RAWLOAD_AT(w_,tok0,rs,re,h)
#define ITEM_DECODE(it_,b_,n_,h_,cidx_,tok0_,rs_,re_) { if ((it_)<2048){ b_=(it_)>>10; n_=((it_)>>3)&127; h_=(it_)&7; cidx_=n_+4; tok0_=b_*8192+n_*64; rs_=tok0_; re_=tok0_+64; } \
      else { int j_=(it_)-2048; b_=j_>>5; n_=(j_>>3)&3; h_=j_&7; cidx_=n_; tok0_=16384+b_*256+n_*64; rs_=16384+b_*256; re_=rs_+256; } }
    if (!have_raw) RAWLOAD(0);
    _Pragma("unroll 1") for (int which=0; which<3; ++which){
      asm volatile("" : "+v"(tid));
      RAWPUT1(rp0,tid); RAWPUT1(rp1,tid+512); RAWPUT1(rp2,tid+1024);
      if (which<2) RAWLOAD(which+1);
      __syncthreads();
      int c=tid&127, tg=tid>>7; int ch=which*1024+h*128+c;
      float w0=p.dn_conv_w[ch], w1=p.dn_conv_w[3072+ch], w2=p.dn_conv_w[6144+ch], w3=p.dn_conv_w[9216+ch], w4=p.dn_conv_w[12288+ch];
      float o16[16];
      { float rw[20];
        _Pragma("unroll") for (int i=0;i<20;++i) rw[i]=raw[(tg*16+i)*128+c];
        _Pragma("unroll") for (int i=0;i<16;++i){
          float a=w0*rw[i]+w1*rw[i+1]+w2*rw[i+2]+w3*rw[i+3]+w4*rw[i+4];
          o16[i]=a/(1.f+__expf(-a)); } }
      if (which==2){
        char* dst=bv+(size_t)(c>>1)*stride+(c&1)*128+tg*32;
        uint4 p0, p1;
        p0.x=pack2(o16[0],o16[1]); p0.y=pack2(o16[2],o16[3]); p0.z=pack2(o16[4],o16[5]); p0.w=pack2(o16[6],o16[7]);
        p1.x=pack2(o16[8],o16[9]); p1.y=pack2(o16[10],o16[11]); p1.z=pack2(o16[12],o16[13]); p1.w=pack2(o16[14],o16[15]);
        *(uint4*)dst=p0; *(uint4*)(dst+16)=p1;
      } else {
        _Pragma("unroll") for (int i=0;i<16;++i) tmp[(tg*16+i)*128+c]=o16[i];
        __syncthreads();
        { int t=tid>>3, c0=(tid&7)*16; float ss=0.f;
          _Pragma("unroll") for(int cc=0;cc<16;++cc){ float s_=tmp[t*128+c0+cc]; ss+=s_*s_; }
          ss+=__shfl_xor(ss,1); ss+=__shfl_xor(ss,2); ss+=__shfl_xor(ss,4);
          if ((tid&7)==0) scl[t]=rsqrtf(ss+EPSV)*(which==0?0.08838834764831845f:1.f); }
        __syncthreads();
        char* sdst= which==0?qs:ks;
        _Pragma("unroll") for (int i=0;i<16;++i){ o16[i]*=scl[tg*16+i]; *(u16*)(sdst+(tg*16+i)*272+c*2)=f2bf(o16[i]); }
        if (which==0){ _Pragma("unroll") for (int i=0;i<16;++i) *(u16*)(bq+(size_t)(tg*16+i)*stride+c*2)=f2bf(o16[i]); }
        else { char* dst=bk+(size_t)(c>>1)*stride+(c&1)*128+tg*32;
          uint4 p0, p1;
          p0.x=pack2(o16[0],o16[1]); p0.y=pack2(o16[2],o16[3]); p0.z=pack2(o16[4],o16[5]); p0.w=pack2(o16[6],o16[7]);
          p1.x=pack2(o16[8],o16[9]); p1.y=pack2(o16[10],o16[11]); p1.z=pack2(o16[12],o16[13]); p1.w=pack2(o16[14],o16[15]);
          *(uint4*)dst=p0; *(uint4*)(dst+16)=p1; }
      }
      __syncthreads();
    }
    { int nx=item+gridDim.x; have_raw=false;
      if (nx<2112){ int b2,n2,h2,c2,t2,rs2,re2; ITEM_DECODE(nx,b2,n2,h2,c2,t2,rs2,re2); (void)c2; RAWLOAD_AT(0,t2,rs2,re2,h2); have_raw=true; } }
    { int r=lane&15, kg=lane>>4;
      for (int tt=0; tt<2; ++tt){ int t=wid*2+tt; int mt=t>>2, nt=t&3;
        f32x4 akk={0.f,0.f,0.f,0.f}, aqk={0.f,0.f,0.f,0.f};
        _Pragma("unroll") for (int k4=0;k4<4;++k4){
          bf16x8 Bk=*(const bf16x8*)(ks+(nt*16+r)*272+(k4*32+kg*8)*2);
          bf16x8 Ak=*(const bf16x8*)(ks+(mt*16+r)*272+(k4*32+kg*8)*2);
          bf16x8 Aq=*(const bf16x8*)(qs+(mt*16+r)*272+(k4*32+kg*8)*2);
          akk=__builtin_amdgcn_mfma_f32_16x16x32_bf16(Ak,Bk,akk,0,0,0);
          aqk=__builtin_amdgcn_mfma_f32_16x16x32_bf16(Aq,Bk,aqk,0,0,0); }
        int jj=nt*16+r; float gfj=gcf[jj], gbj=gcb[jj];
        _Pragma("unroll") for (int j=0;j<4;++j){ int i=mt*16+kg*4+j;
          float ef=__expf(fminf(gcf[i]-gfj,0.f)), eb=__expf(fminf(gcb[i]-gbj,0.f));
          float lf=(jj<i)?bef[i]*akk[j]*ef:0.f;
          float af=(jj<=i)?aqk[j]*ef:0.f;
          float lb=(jj>i)?beb[i]*akk[j]*eb:0.f;
          float ab=(jj>=i)?aqk[j]*eb:0.f;
          Lf[i*64+jj]=lf; Lb[(63-i)*64+(63-jj)]=lb;
          *(u16*)(taf+16384+(i*64+jj)*2)=f2bf(af); *(u16*)(tab+16384+(i*64+jj)*2)=f2bf(ab); }
      } }
    __syncthreads();
    if (wid<2){
      int lbase = wid==0 ? 102400 : 118784; asm volatile("" : "+v"(lbase));
      float Tc[64];
      float4 lcur[16], lnxt[16];
      _Pragma("unroll") for (int r4=0;r4<16;++r4){ lcur[r4]=make_float4(0.f,0.f,0.f,0.f); lnxt[r4]=lcur[r4]; }
      _Pragma("unroll") for (int r=0;r<64;++r){
        if (r+1<64){ _Pragma("unroll") for (int r4=0;r4<(r+1+3)/4;++r4) lnxt[r4]=*(const float4*)(smem+lbase+((r+1)*64+r4*4)*4); }
        float a0=(r==lane)?1.f:0.f, a1=0.f, a2=0.f, a3=0.f;
        _Pragma("unroll") for (int r4=0;r4<(r+3)/4;++r4){ float4 l=lcur[r4];
          if (r4*4+0<r) a0-=l.x*Tc[r4*4+0]; if (r4*4+1<r) a1-=l.y*Tc[r4*4+1]; if (r4*4+2<r) a2-=l.z*Tc[r4*4+2]; if (r4*4+3<r) a3-=l.w*Tc[r4*4+3]; }
        Tc[r]=(a0+a1)+(a2+a3);
        _Pragma("unroll") for (int r4=0;r4<16;++r4) lcur[r4]=lnxt[r4];
        asm volatile("":::"memory"); }
      if (wid==0){ int c=lane; float su=bef[c], sw=su*__expf(gcf[c]);
        _Pragma("unroll") for (int r=0;r<64;++r){ *(u16*)(taf+(r*64+c)*2)=f2bf(Tc[r]*sw); *(u16*)(taf+8192+(r*64+c)*2)=f2bf(Tc[r]*su); } }
      else { int j=63-lane; float su=beb[j], sw=su*__expf(gcb[j]);
        _Pragma("unroll") for (int r=0;r<64;++r){ int i=63-r; *(u16*)(tab+(i*64+j)*2)=f2bf(Tc[r]*sw); *(u16*)(tab+8192+(i*64+j)*2)=f2bf(Tc[r]*su); } }
    }
  }
}

#define SQ 0
#define SKT 17408
#define SVT 35840
#define STW 54272
#define STU 63488
#define SAT 72704
#define SGC 81920
#define SWB 82176
__device__ __forceinline__ bf16x8 lds128(int off){ return *(const bf16x8*)(smem+off); }
__device__ __forceinline__ bf16x8 lds64x2(int off){ uint2 a=*(const uint2*)(smem+off), b=*(const uint2*)(smem+off+32); u32x4 t={a.x,a.y,b.x,b.y}; return __builtin_bit_cast(bf16x8,t); }
__device__ __forceinline__ bf16x8 packfrag(f32x4 d0, f32x4 d1){ u32x4 t={pack2(d0[0],d0[1]),pack2(d0[2],d0[3]),pack2(d1[0],d1[1]),pack2(d1[2],d1[3])}; return __builtin_bit_cast(bf16x8,t); }
#define MF(a,b,c) __builtin_amdgcn_mfma_f32_16x16x32_bf16(a,b,c,0,0,0)
__device__ __forceinline__ void phase_scan(KP kp_){ asm volatile("" : "+s"(kp_)); const Params p=load_params(kp_);
  int ftid=threadIdx.x; asm volatile("" : "+v"(ftid));
  int tid=ftid, lane=tid&63, wv=tid>>6, r=lane&15, kg=lane>>4;
  for (int item=blockIdx.x; item<32; item+=gridDim.x){
    int d=item&1, h=(item>>1)&7, b=item>>4;
    char* tabase = d ? (p.ws+OFF_TAB) : (char*)p.out;
    f32x4 Sacc[8];
    _Pragma("unroll") for (int i=0;i<8;++i) Sacc[i]=f32x4{0.f,0.f,0.f,0.f};
    u32x4 pq0A,pq1A,pk0A,pk1A,pv0A,pv1A,pt0A,pt1A,pt2A; float pgA;
    u32x4 pq0B,pq1B,pk0B,pk1B,pv0B,pv1B,pt0B,pt1B,pt2B; float pgB;
#define PREFETCH(X,s_) { int s__=(s_); int cidx=s__<4?(d?3-s__:s__):4+(d?131-s__:s__-4); char *bq,*bk,*bv; int stride; slot_bases(p.ws,b,cidx,h,bq,bk,bv,stride); \
      const char* ta=tabase+(size_t)((b*8+h)*132+cidx)*TA_STRIDE; \
      { int e=tid; pq0##X=*(const u32x4*)(bq+(size_t)(e>>4)*stride+(e&15)*16); int row=e>>3; size_t ko=(size_t)(row>>1)*stride+(row&1)*128+(e&7)*16; pk0##X=*(const u32x4*)(bk+ko); pv0##X=*(const u32x4*)(bv+ko); } \
      { int e=tid+512; pq1##X=*(const u32x4*)(bq+(size_t)(e>>4)*stride+(e&15)*16); int row=e>>3; size_t ko=(size_t)(row>>1)*stride+(row&1)*128+(e&7)*16; pk1##X=*(const u32x4*)(bk+ko); pv1##X=*(const u32x4*)(bv+ko); } \
      pt0##X=*(const u32x4*)(ta+tid*16); pt1##X=*(const u32x4*)(ta+8192+tid*16); pt2##X=*(const u32x4*)(ta+16384+tid*16); \
      pg##X = tid<64 ? *(const float*)(ta+24576+tid*4) : 0.f; }
#define FILL(X) { { int e=tid; *(u32x4*)(smem+SQ+(e>>4)*272+(e&15)*16)=pq0##X; int row=e>>3; *(u32x4*)(smem+SKT+row*144+(e&7)*16)=pk0##X; *(u32x4*)(smem+SVT+row*144+(e&7)*16)=pv0##X; } \
      { int e=tid+512; *(u32x4*)(smem+SQ+(e>>4)*272+(e&15)*16)=pq1##X; int row=e>>3; *(u32x4*)(smem+SKT+row*144+(e&7)*16)=pk1##X; *(u32x4*)(smem+SVT+row*144+(e&7)*16)=pv1##X; } \
      { int row=tid>>3, c16=tid&7; *(u32x4*)(smem+STW+row*144+c16*16)=pt0##X; *(u32x4*)(smem+STU+row*144+c16*16)=pt1##X; *(u32x4*)(smem+SAT+row*144+c16*16)=pt2##X; } \
      if (tid<64) *(float*)(smem+SGC+tid*4)=pg##X; }
    __syncthreads();
    PREFETCH(A,0); FILL(A);
    __syncthreads();
    for (int s2=0; s2<132; s2+=2){
      { const int s=s2;
        if (s+1<132) PREFETCH(A,s+1);
      f32x4 wacc[4], vn[4];
      _Pragma("unroll") for (int i=0;i<4;++i){ wacc[i]=f32x4{0.f,0.f,0.f,0.f}; vn[i]=f32x4{0.f,0.f,0.f,0.f}; }
      _Pragma("unroll") for (int ks=0;ks<2;++ks){ int kb=(ks*32+kg*8)*2;
        bf16x8 A=lds128(SKT+(wv*16+r)*144+kb);
        bf16x8 Bv=lds128(SVT+(wv*16+r)*144+kb);
        _Pragma("unroll") for (int t=0;t<4;++t){
          wacc[t]=MF(A, lds128(STW+(t*16+r)*144+kb), wacc[t]);
          vn[t]=MF(lds128(STU+(t*16+r)*144+kb), Bv, vn[t]); } }
      _Pragma("unroll") for (int t=0;t<4;++t){ uint2 pk2; pk2.x=pack2(-wacc[t][0],-wacc[t][1]); pk2.y=pack2(-wacc[t][2],-wacc[t][3]);
        *(uint2*)(smem+SWB+(t*16+r)*272+(wv*16+kg*4)*2)=pk2; }
      __syncthreads();
      bf16x8 Sf[4];
      _Pragma("unroll") for (int q=0;q<4;++q) Sf[q]=packfrag(Sacc[2*q],Sacc[2*q+1]);
      f32x4 oacc[4];
      _Pragma("unroll") for (int i=0;i<4;++i) oacc[i]=f32x4{0.f,0.f,0.f,0.f};
      _Pragma("unroll") for (int q=0;q<4;++q){ int kb=(32*q+kg*4)*2;
        _Pragma("unroll") for (int t=0;t<4;++t){
          vn[t]=MF(lds64x2(SWB+(t*16+r)*272+kb), Sf[q], vn[t]);
          oacc[t]=MF(lds64x2(SQ+(t*16+r)*272+kb), Sf[q], oacc[t]); } }
      const float* gcs=(const float*)(smem+SGC);
      float gl = d ? gcs[0] : gcs[63];
      float gam=__expf(gl);
      f32x4 vs[4];
      _Pragma("unroll") for (int t=0;t<4;++t){ float4 g4=*(const float4*)(gcs+t*16+kg*4);
        oacc[t][0]*=__expf(g4.x); oacc[t][1]*=__expf(g4.y); oacc[t][2]*=__expf(g4.z); oacc[t][3]*=__expf(g4.w);
        vs[t][0]=vn[t][0]*__expf(gl-g4.x); vs[t][1]=vn[t][1]*__expf(gl-g4.y); vs[t][2]=vn[t][2]*__expf(gl-g4.z); vs[t][3]=vn[t][3]*__expf(gl-g4.w); }
      bf16x8 Vf[2], Wf[2];
      _Pragma("unroll") for (int q=0;q<2;++q){ Vf[q]=packfrag(vn[2*q],vn[2*q+1]); Wf[q]=packfrag(vs[2*q],vs[2*q+1]); }
      _Pragma("unroll") for (int q=0;q<2;++q){ int kb=(32*q+kg*4)*2;
        _Pragma("unroll") for (int t=0;t<4;++t) oacc[t]=MF(lds64x2(SAT+(t*16+r)*144+kb), Vf[q], oacc[t]); }
      _Pragma("unroll") for (int m8=0;m8<8;++m8){ Sacc[m8][0]*=gam; Sacc[m8][1]*=gam; Sacc[m8][2]*=gam; Sacc[m8][3]*=gam; }
      _Pragma("unroll") for (int q=0;q<2;++q){ int kb=(32*q+kg*4)*2;
        _Pragma("unroll") for (int m8=0;m8<8;++m8) Sacc[m8]=MF(lds64x2(SKT+(m8*16+r)*144+kb), Wf[q], Sacc[m8]); }
      if (s>=4){ int cidx=4+(d?131-s:s-4); char* op=tabase+(size_t)((b*8+h)*132+cidx)*TA_STRIDE;
        _Pragma("unroll") for (int t=0;t<4;++t) _Pragma("unroll") for (int j=0;j<4;++j)
          *(u16*)(op+((t*16+kg*4+j)*128+wv*16+r)*2)=f2bf(oacc[t][j]); }
        __syncthreads();
        FILL(A);
        __syncthreads();
      }
      { const int s=s2+1;
        if (s+1<132) PREFETCH(A,s+1);
      f32x4 wacc[4], vn[4];
      _Pragma("unroll") for (int i=0;i<4;++i){ wacc[i]=f32x4{0.f,0.f,0.f,0.f}; vn[i]=f32x4{0.f,0.f,0.f,0.f}; }
      _Pragma("unroll") for (int ks=0;ks<2;++ks){ int kb=(ks*32+kg*8)*2;
        bf16x8 A=lds128(SKT+(wv*16+r)*144+kb);
        bf16x8 Bv=lds128(SVT+(wv*16+r)*144+kb);
        _Pragma("unroll") for (int t=0;t<4;++t){
          wacc[t]=MF(A, lds128(STW+(t*16+r)*144+kb), wacc[t]);
          vn[t]=MF(lds128(STU+(t*16+r)*144+kb), Bv, vn[t]); } }
      _Pragma("unroll") for (int t=0;t<4;++t){ uint2 pk2; pk2.x=pack2(-wacc[t][0],-wacc[t][1]); pk2.y=pack2(-wacc[t][2],-wacc[t][3]);
        *(uint2*)(smem+SWB+(t*16+r)*272+(wv*16+kg*4)*2)=pk2; }
      __syncthreads();
      bf16x8 Sf[4];
      _Pragma("unroll") for (int q=0;q<4;++q) Sf[q]=packfrag(Sacc[2*q],Sacc[2*q+1]);
      f32x4 oacc[4];
      _Pragma("unroll") for (int i=0;i<4;++i) oacc[i]=f32x4{0.f,0.f,0.f,0.f};
      _Pragma("unroll") for (int q=0;q<4;++q){ int kb=(32*q+kg*4)*2;
        _Pragma("unroll") for (int t=0;t<4;++t){
          vn[t]=MF(lds64x2(SWB+(t*16+r)*272+kb), Sf[q], vn[t]);
          oacc[t]=MF(lds64x2(SQ+(t*16+r)*272+kb), Sf[q], oacc[t]); } }
      const float* gcs=(const float*)(smem+SGC);
      float gl = d ? gcs[0] : gcs[63];
      float gam=__expf(gl);
      f32x4 vs[4];
      _Pragma("unroll") for (int t=0;t<4;++t){ float4 g4=*(const float4*)(gcs+t*16+kg*4);
        oacc[t][0]*=__expf(g4.x); oacc[t][1]*=__expf(g4.y); oacc[t][2]*=__expf(g4.z); oacc[t][3]*=__expf(g4.w);
        vs[t][0]=vn[t][0]*__expf(gl-g4.x); vs[t][1]=vn[t][1]*__expf(gl-g4.y); vs[t][2]=vn[t][2]*__expf(gl-g4.z); vs[t][3]=vn[t][3]*__expf(gl-g4.w); }
      bf16x8 Vf[2], Wf[2];
      _Pragma("unroll") for (int q=0;q<2;++q){ Vf[q]=packfrag(vn[2*q],vn[2*q+1]); Wf[q]=packfrag(vs[2*q],vs[2*q+1]); }
      _Pragma("unroll") for (int q=0;q<2;++q){ int kb=(32*q+kg*4)*2;
        _Pragma("unroll") for (int t=0;t<4;++t) oacc[t]=MF(lds64x2(SAT+(t*16+r)*144+kb), Vf[q], oacc[t]); }
      _Pragma("unroll") for (int m8=0;m8<8;++m8){ Sacc[m8][0]*=gam; Sacc[m8][1]*=gam; Sacc[m8][2]*=gam; Sacc[m8][3]*=gam; }
      _Pragma("unroll") for (int q=0;q<2;++q){ int kb=(32*q+kg*4)*2;
        _Pragma("unroll") for (int m8=0;m8<8;++m8) Sacc[m8]=MF(lds64x2(SKT+(m8*16+r)*144+kb), Wf[q], Sacc[m8]); }
      if (s>=4){ int cidx=4+(d?131-s:s-4); char* op=tabase+(size_t)((b*8+h)*132+cidx)*TA_STRIDE;
        _Pragma("unroll") for (int t=0;t<4;++t) _Pragma("unroll") for (int j=0;j<4;++j)
          *(u16*)(op+((t*16+kg*4+j)*128+wv*16+r)*2)=f2bf(oacc[t][j]); }
        __syncthreads();
        if (s+1<132) FILL(A);
        __syncthreads();
      }
    }
  }
}

__device__ __forceinline__ void phase_oa(KP kp_){ asm volatile("" : "+s"(kp_)); const Params p=load_params(kp_);
  int ftid=threadIdx.x; asm volatile("" : "+v"(ftid));
  int lane=ftid&63, wid=ftid>>6;
  const char* taf=(const char*)p.out; const char* tab=(const char*)(p.ws+OFF_TAB);
  u16* ZA=(u16*)(p.ws+OFF_ZA);
  float g0=p.dn_norm_g[lane*2], g1=p.dn_norm_g[lane*2+1];
  for (int it=blockIdx.x*8+wid; it<16384*8; it+=gridDim.x*8){
    int tok=it>>3, h=it&7; int b=tok>>13, n=(tok>>6)&127, tl=tok&63;
    size_t ia=(size_t)((b*8+h)*132+4+n)*TA_STRIDE + (size_t)(tl*128+lane*2)*2;
    unsigned a=*(const unsigned*)(taf+ia), bb=*(const unsigned*)(tab+ia);
    size_t off=(size_t)it*128+lane*2;
    unsigned z=*(const unsigned*)(ZA+off);
    float o0=bf2f((u16)(a&0xffff))+bf2f((u16)(bb&0xffff)), o1=bf2f((u16)(a>>16))+bf2f((u16)(bb>>16));
    float ss=wave_sum(o0*o0+o1*o1); float r=rsqrtf(ss*(1.f/128.f)+EPSV);
    float r0=o0*r*g0*bf2f((u16)(z&0xffff)), r1=o1*r*g1*bf2f((u16)(z>>16));
    *(unsigned*)(ZA+off)=pack2(r0,r1);
  }
}

__device__ __forceinline__ void phase_merge(KP kp_){ asm volatile("" : "+s"(kp_)); const Params p=load_params(kp_);
  const u16* oa=(const u16*)(p.ws+OFF_OA); const u16* yb=(const u16*)(p.ws+OFF_YB);
  const u16* wpa=(const u16*)(p.ws+OFF_WTPA); const u16* wpb=(const u16*)(p.ws+OFF_WTPB);
  const u16* PG=(const u16*)p.out; float* MA=(float*)(p.ws+OFF_MA); u16* M=(u16*)(p.ws+OFF_M);
  for (int it=blockIdx.x; it<256; it+=gridDim.x){
    int ct=it&3, rt=it>>2;
    f32x4 acc[2][2][4][2];
    gemm_core(wpa, oa, ct*256, rt*256, acc);
    EPIG_BEGIN
      uint2 g[8];
      EPIG_FOR g[idx]=*(const uint2*)(PG+(size_t)(rt*256+C0)*2048+ct*256+R0); EPIG_ENDFOR
      EPIG_FOR f32x4 v=acc[ai][bj][m][n]; uint2 gg=g[idx];
        float4 r; r.x=v[0]*bf2f((u16)(gg.x&0xffff)); r.y=v[1]*bf2f((u16)(gg.x>>16)); r.z=v[2]*bf2f((u16)(gg.y&0xffff)); r.w=v[3]*bf2f((u16)(gg.y>>16));
        *(float4*)(MA+(size_t)(rt*256+C0)*1024+ct*256+R0)=r; EPIG_ENDFOR
    EPIG_END
  }
  for (int it=blockIdx.x; it<256; it+=gridDim.x){
    int ct=it&3, rt=it>>2;
    f32x4 acc[2][2][4][2];
    gemm_core(wpb, yb, ct*256, rt*256, acc);
    EPIG_BEGIN
      uint2 g[8]; float4 ra[8];
      EPIG_FOR g[idx]=*(const uint2*)(PG+(size_t)(rt*256+C0)*2048+1024+ct*256+R0); ra[idx]=*(const float4*)(MA+(size_t)(rt*256+C0)*1024+ct*256+R0); EPIG_ENDFOR
      EPIG_FOR f32x4 v=acc[ai][bj][m][n]; uint2 gg=g[idx]; float4 r=ra[idx];
        r.x+=v[0]*bf2f((u16)(gg.x&0xffff)); r.y+=v[1]*bf2f((u16)(gg.x>>16)); r.z+=v[2]*bf2f((u16)(gg.y&0xffff)); r.w+=v[3]*bf2f((u16)(gg.y>>16));
        uint2 pk; pk.x=pack2(r.x,r.y); pk.y=pack2(r.z,r.w);
        *(uint2*)(M+(size_t)(rt*256+C0)*1024+ct*256+R0)=pk; EPIG_ENDFOR
    EPIG_END
  }
}
__device__ __forceinline__ void phase_out(KP kp_){ asm volatile("" : "+s"(kp_)); const Params p=load_params(kp_);
  const u16* M=(const u16*)(p.ws+OFF_M); const u16* wo=(const u16*)(p.ws+OFF_WTOUT);
  const float* modv=(const float*)(p.ws+OFF_MOD);
  for (int it=blockIdx.x; it<256; it+=gridDim.x){
    int ct=it&3, rt=it>>2;
    f32x4 acc[2][2][4][2];
    gemm_core(wo, M, ct*256, rt*256, acc);
    EPIG_BEGIN
      float4 xa[8], ga[8];
      EPIG_FOR int tok=rt*256+C0; xa[idx]=*(const float4*)(p.x+(size_t)tok*1024+ct*256+R0); ga[idx]=*(const float4*)(modv+(tok>>13)*3072+2048+ct*256+R0); EPIG_ENDFOR
      EPIG_FOR f32x4 v=acc[ai][bj][m][n]; float4 xv=xa[idx], gt=ga[idx];
        float4 r; r.x=xv.x+gt.x*v[0]; r.y=xv.y+gt.y*v[1]; r.z=xv.z+gt.z*v[2]; r.w=xv.w+gt.w*v[3];
        *(float4*)(p.out+(size_t)(rt*256+C0)*1024+ct*256+R0)=r; EPIG_ENDFOR
    EPIG_END
  }
}

__device__ __forceinline__ void phase_final(KP kp_){ asm volatile("" : "+s"(kp_)); const Params p=load_params(kp_);
  int ftid=threadIdx.x; asm volatile("" : "+v"(ftid));
  int lane=ftid&63, wid=ftid>>6;
  for (int r=blockIdx.x*8+wid; r<16384; r+=gridDim.x*8){
    float4 xv[4]; float ss=0.f;
    for(int i=0;i<4;++i){ xv[i]=*(const float4*)(p.out+(size_t)r*1024+lane*4+256*i); ss+=xv[i].x*xv[i].x+xv[i].y*xv[i].y+xv[i].z*xv[i].z+xv[i].w*xv[i].w; }
    ss=wave_sum(ss); float rstd=rsqrtf(ss*(1.f/1024.f)+EPSV);
    for(int i=0;i<4;++i){ int col=lane*4+256*i; float4 v=xv[i]; float4 g=*(const float4*)(p.final_g+col);
      v.x*=rstd*g.x; v.y*=rstd*g.y; v.z*=rstd*g.z; v.w*=rstd*g.w; *(float4*)(p.out+(size_t)r*1024+col)=v; }
  }
}

#define XB_TMO      128
#define XB_XCNT(j)  (256  + 64 * (j))
#define XB_XSUB(j)  (1280 + 64 * (j))
#define XB_XGEN(j)  (2304 + 64 * (j))
#define XB_TOP      3328
#define XB_TOPGEN   3392
#define XCD_BAR_WORDS 3456
#define XB_SPIN_CAP (1u << 18)
#define LAS __attribute__((address_space(3)))

__device__ __forceinline__ unsigned xb_ld(unsigned* p)              { return __hip_atomic_load(p, __ATOMIC_RELAXED, __HIP_MEMORY_SCOPE_AGENT); }
__device__ __forceinline__ unsigned xb_add(unsigned* p, unsigned v) { return __hip_atomic_fetch_add(p, v, __ATOMIC_RELAXED, __HIP_MEMORY_SCOPE_AGENT); }
__device__ __forceinline__ unsigned xb_xcc_id() { return (unsigned)__builtin_amdgcn_s_getreg((3 << 11) | 20) & 0xFu; }
#define XB_SPIN(cond, bar) do { unsigned _sp = 0; while (cond) { __builtin_amdgcn_s_sleep(0); \
    if ((++_sp & 255u) == 0u) { if (xb_ld(&(bar)[XB_TMO])) break; if (_sp > XB_SPIN_CAP) { atomicAdd(&(bar)[XB_TMO], 1u); break; } } } } while (0)

struct XcdBarrier {
    unsigned* bar; unsigned x;
    volatile LAS unsigned* st;
};

__device__ __forceinline__ XcdBarrier xcd_barrier_post(unsigned* bar, volatile LAS unsigned* st) {
    XcdBarrier b; b.bar = bar; b.x = xb_xcc_id(); b.st = st;
    if (threadIdx.x == 0) (void)xb_add(&bar[XB_XCNT(b.x)], 1u);
    return b;
}
__device__ __forceinline__ void xcd_barrier_complete(unsigned* bar, unsigned x, unsigned& nloc, unsigned& nx) {
    const unsigned G = gridDim.x * gridDim.y * gridDim.z;
    unsigned sum, cnt, mine, sp = 0u;
    for (;;) {
        sum = 0u; cnt = 0u; mine = 0u;
#pragma unroll
        for (unsigned j = 0; j < 16; ++j) { const unsigned c = xb_ld(&bar[XB_XCNT(j)]); sum += c; cnt += (c > 0u) ? 1u : 0u; mine = (j == x) ? c : mine; }
        if (sum == G) break;
        __builtin_amdgcn_s_sleep(1);
        if ((++sp & 255u) == 0u) { if (xb_ld(&bar[XB_TMO])) break; if (sp > XB_SPIN_CAP) { atomicAdd(&bar[XB_TMO], 1u); break; } }
    }
    nloc = mine > 0u ? mine : 1u; nx = cnt > 0u ? cnt : 1u;
}

__device__ __forceinline__ void xcd_barrier(const XcdBarrier& b) {
    asm volatile("s_waitcnt vmcnt(0)" ::: "memory");
    __syncthreads();
    if (threadIdx.x == 0) {
        unsigned* bar = b.bar;
        __builtin_amdgcn_s_waitcnt(0);
        unsigned nloc = b.st[0], nx = b.st[1];
        if (nloc == 0u) { xcd_barrier_complete(bar, b.x, nloc, nx); b.st[0] = nloc; b.st[1] = nx; }
        const unsigned old = xb_add(&bar[XB_XSUB(b.x)], 1u);
        const unsigned gen = old / nloc;
        if (old + 1u == (gen + 1u) * nloc) {
            __builtin_amdgcn_fence(__ATOMIC_RELEASE, "agent");
            asm volatile("s_waitcnt vmcnt(0)" ::: "memory");
            const unsigned og = xb_add(&bar[XB_TOP], 1u);
            const unsigned tg = og / nx;
            if (og + 1u == (tg + 1u) * nx) xb_add(&bar[XB_TOPGEN], 1u);
            else XB_SPIN(xb_ld(&bar[XB_TOPGEN]) == tg, bar);
            __builtin_amdgcn_fence(__ATOMIC_ACQUIRE, "agent");
            xb_add(&bar[XB_XGEN(b.x)], 1u);
            asm volatile("s_waitcnt vmcnt(0)" ::: "memory");
        } else {
            XB_SPIN(xb_ld(&bar[XB_XGEN(b.x)]) == gen, bar);
            __builtin_amdgcn_fence(__ATOMIC_ACQUIRE, "agent");
            asm volatile("s_waitcnt vmcnt(0)" ::: "memory");
        }
    }
    __syncthreads();
}


__global__ void __launch_bounds__(NTH) mega(Params p_arg){
  cg::grid_group grid = cg::this_grid();
  KP kp = (KP)__builtin_amdgcn_kernarg_segment_ptr();
  volatile LAS unsigned* xst=(volatile LAS unsigned*)((LAS char*)smem+(LDS_BYTES-16));
  if (threadIdx.x==0){ xst[0]=0u; xst[1]=0u; }
  __syncthreads();
  XcdBarrier xb;
  { unsigned long long wsp=kp[28]; xb=xcd_barrier_post((unsigned*)((char*)wsp+OFF_BAR), xst); }
  int rep_a, rep_b;
  { unsigned long long rr=kp[29]; rep_a=(int)(rr&0xffffffffull); rep_b=(int)(rr>>32); }
  for (int r_=0;r_<((rep_b>>8)&255);++r_){ phase_prep(kp);
    if (rep_a==0x7fffffff) grid.sync();
    xcd_barrier(xb); }
  phase_h(kp);        xcd_barrier(xb);
  for (int r_=0;r_<(rep_b&255);++r_){ phase_gemm_dn(kp);  xcd_barrier(xb); }
  phase_dnprep(kp);   xcd_barrier(xb);
  if (gridDim.x>64){ if (blockIdx.x<32) phase_scan(kp); else phase_side(kp,blockIdx.x-32,gridDim.x-32); }
  else { phase_scan(kp); phase_side(kp,blockIdx.x,gridDim.x); }
  xcd_barrier(xb);
  phase_oa(kp);       xcd_barrier(xb);
  for (int hf=0; hf<2; ++hf){
    phase_gemm_hy(kp,hf); xcd_barrier(xb);
    phase_hyena(kp,hf);   xcd_barrier(xb);
  }
  phase_ybt(kp);    xcd_barrier(xb);
  phase_merge(kp);  xcd_barrier(xb);
  phase_out(kp);    xcd_barrier(xb);
  phase_final(kp);
}

extern "C" void kernel_launch(void* const* d_in, const int* in_sizes, int n_in,
                              void* d_out, int out_size, void* d_ws, size_t ws_size,
                              hipStream_t stream) {
  static int grid_blocks = 0;
  if (!grid_blocks) {
    int dev=0, cus=0, per_cu=0;
    hipGetDevice(&dev);
    hipDeviceGetAttribute(&cus, hipDeviceAttributeMultiprocessorCount, dev);
    hipFuncSetAttribute((const void*)mega, hipFuncAttributeMaxDynamicSharedMemorySize, LDS_BYTES);
    hipOccupancyMaxActiveBlocksPerMultiprocessor(&per_cu, (const void*)mega, NTH, LDS_BYTES);
    if (per_cu < 1) per_cu = 1;
    grid_blocks = cus * per_cu;
    if (grid_blocks > 256) grid_blocks = 256;
  }
  if (ws_size < WS_NEED) { fprintf(stderr, "workspace too small: %zu < %zu\n", ws_size, (size_t)WS_NEED); return; }
  Params p{};
  const float** pp = (const float**)&p;
  for (int i=0;i<27;++i) pp[i]=(const float*)d_in[i];
  p.out=(float*)d_out; p.ws=(char*)d_ws; p.rep_a=REP_A; p.rep_b=REP_B;
  hipMemsetAsync((char*)d_ws+OFF_BAR, 0, 16384, stream);
  void* args[] = {&p};
  hipError_t e = hipLaunchCooperativeKernel((const void*)mega, dim3(grid_blocks), dim3(NTH), args, LDS_BYTES, stream);
  if (e != hipSuccess) fprintf(stderr, "cooperative launch failed: %s (grid %d)\n", hipGetErrorString(e), grid_blocks);
}
```

```cpp
#include <hip/hip_runtime.h>
#include <hip/hip_bf16.h>
#include <hip/hip_cooperative_groups.h>
#include <cstdio>
namespace cg = cooperative_groups;

typedef unsigned short u16;
using bf16x8 = __attribute__((ext_vector_type(8))) short;
using f32x4 = __attribute__((ext_vector_type(4))) float;
typedef unsigned u32x4 __attribute__((ext_vector_type(4)));

#define NTH 512
#ifndef REP_A
#define REP_A 1
#endif
#ifndef REP_B
#define REP_B 0x101
#endif
#define EPSV 1e-6f
constexpr int LDS_BYTES = 131072 + 8192;

constexpr size_t SZ_WTIN = (size_t)10496 * 1024 * 2;
constexpr size_t SZ_HBUF = (size_t)16896 * 1024 * 2;
constexpr size_t OFF_WTIN = 0;
constexpr size_t OFF_HBUF = OFF_WTIN + SZ_WTIN;
constexpr size_t OFF_WTPA = OFF_HBUF + SZ_HBUF;
constexpr size_t OFF_WTPB = OFF_WTPA + 2097152;
constexpr size_t OFF_WTOUT= OFF_WTPB + 2097152;
constexpr size_t OFF_MOD  = OFF_WTOUT + 2097152;
constexpr size_t OFF_A3   = OFF_MOD + 36864;
constexpr size_t OFF_TW   = OFF_A3 + 2097152;
constexpr size_t OFF_GATES= OFF_TW + 131072;
constexpr size_t OFF_BAR  = OFF_GATES + (size_t)16896*32*4;
constexpr size_t OFF_R1C  = OFF_BAR + 16384;
constexpr size_t OFF_BIG  = OFF_R1C + (size_t)64*49152;
constexpr size_t TA_STRIDE= 25600;
constexpr size_t SZ_TA    = (size_t)16*132*TA_STRIDE;
constexpr size_t OFF_R1   = OFF_BIG;
constexpr size_t OFF_TAB  = OFF_R1 + (size_t)16896*3072*2;
constexpr size_t OFF_ZA   = OFF_TAB + SZ_TA;
constexpr size_t OFF_OA   = OFF_ZA;
constexpr size_t OFF_PHYT = OFF_BIG;
constexpr size_t OFF_YBT  = OFF_BIG + (size_t)2048*16384*2;
constexpr size_t OFF_YB   = OFF_BIG;
constexpr size_t OFF_FS   = OFF_YBT + (size_t)16384*1024*2;
constexpr size_t OFF_MA   = OFF_BIG + (size_t)16384*1024*2;
constexpr size_t OFF_M    = OFF_FS;
constexpr size_t WS_NEED  = OFF_ZA + (size_t)16384*1024*2;
static_assert(OFF_FS + (size_t)256*24576*8 <= OFF_ZA, "scratch overlaps oa");

struct Params {
  const float *x,*c,*ctx,*c_ctx,*w_mod,*b_mod,*norm_g,*w_in,*dn_conv_w,*dn_a_log,*dn_dt_bias,*dn_norm_g,
    *hy_conv_w,*hy_conv_b,*f_w1,*f_b1,*f_w2,*f_b2,*f_w3,*f_b3,*f_wout,*f_freq,*hy_bias,*w_pa,*w_pb,*w_out,*final_g;
  float* out;
  char* ws;
  int rep_a, rep_b;
};

extern __shared__ __attribute__((aligned(16))) char smem[];
typedef const __attribute__((address_space(4))) unsigned long long* KP;
__device__ __forceinline__ Params load_params(KP k){
  Params p; unsigned long long* d=(unsigned long long*)&p;
  _Pragma("unroll") for (int i=0;i<(int)(sizeof(Params)/8);++i) d[i]=k[i];
  return p; }

typedef float f32x2_t __attribute__((ext_vector_type(2)));
typedef __bf16 bf16x2_t __attribute__((ext_vector_type(2)));
__device__ __forceinline__ u16 f2bf(float f){ __bf16 h=(__bf16)f; return __builtin_bit_cast(u16,h); }
__device__ __forceinline__ float bf2f(u16 h){ return __uint_as_float(((unsigned)h)<<16); }
__device__ __forceinline__ unsigned pack2(float a, float b){ f32x2_t v={a,b}; bf16x2_t r=__builtin_convertvector(v,bf16x2_t); return __builtin_bit_cast(unsigned,r); }
__device__ __forceinline__ float siluf(float x){ return x/(1.f+__expf(-x)); }
__device__ __forceinline__ float sigmf(float x){ return 1.f/(1.f+__expf(-x)); }
__device__ __forceinline__ float wave_sum(float v){
  for (int o=32;o>=1;o>>=1) v += __shfl_xor(v,o);
  return v;
}

#define HD __device__ __forceinline__
HD float2 cmul(float2 a, float2 b){ return make_float2(a.x*b.x - a.y*b.y, a.x*b.y + a.y*b.x); }
HD float2 cmulc(float2 a, float2 b){ return make_float2(a.x*b.x + a.y*b.y, a.y*b.x - a.x*b.y); }
template<bool INV, bool NOTW>
HD void bf4c(float2* Z, int i0, int i1, int i2, int i3, float2 w1, float2 w2, float2 w3){
  float2 a0=Z[i0], a1=Z[i1], a2=Z[i2], a3=Z[i3];
  if (INV && !NOTW){ a1=cmulc(a1,w1); a2=cmulc(a2,w2); a3=cmulc(a3,w3); }
  float2 s02=make_float2(a0.x+a2.x,a0.y+a2.y), d02=make_float2(a0.x-a2.x,a0.y-a2.y);
  float2 s13=make_float2(a1.x+a3.x,a1.y+a3.y), d13=make_float2(a1.x-a3.x,a1.y-a3.y);
  float2 y0=make_float2(s02.x+s13.x,s02.y+s13.y), y2=make_float2(s02.x-s13.x,s02.y-s13.y);
  float2 ym=make_float2(d02.x+d13.y,d02.y-d13.x);
  float2 yp=make_float2(d02.x-d13.y,d02.y+d13.x);
  float2 y1, y3;
  if (INV){ y1=yp; y3=ym; } else if (NOTW){ y1=ym; y3=yp; } else { y1=cmul(ym,w1); y2=cmul(y2,w2); y3=cmul(yp,w3); }
  Z[i0]=y0; Z[i1]=y1; Z[i2]=y2; Z[i3]=y3;
}
HD int rev4_14(int p){ unsigned r = __brev((unsigned)p) >> 18; return (int)(((r & 0x2AAAu) >> 1) | ((r & 0x1555u) << 1)); }
template<bool INV, int LQ, bool BARRIER=true>
HD void fft_pass(float2* Z, const float2* twA, const float2* twB, int tid){
  constexpr int q=1<<LQ; constexpr int tws=4096>>LQ;
  if (LQ==12){
    _Pragma("unroll 2") for (int i=0;i<8;++i){ int t=tid+512*i; int k=t;
      float2 w1=cmul(twA[k>>6],twB[k&63]), w2=cmul(w1,w1), w3=cmul(w2,w1);
      bf4c<INV,false>(Z,t,t+q,t+2*q,t+3*q,w1,w2,w3); }
  } else if (LQ==10){
    _Pragma("unroll") for (int e=0;e<2;++e){ int j=tid+512*e; int k=j*tws;
      float2 w1=cmul(twA[k>>6],twB[k&63]), w2=cmul(w1,w1), w3=cmul(w2,w1);
      _Pragma("unroll") for (int ip=0;ip<4;++ip){ int base=ip*4096+j; bf4c<INV,false>(Z,base,base+q,base+2*q,base+3*q,w1,w2,w3); } }
  } else {
    int j=tid&(q-1); int base0=((tid>>LQ)<<(LQ+2))+j;
    float2 w1=make_float2(1.f,0.f), w2=w1, w3=w1;
    if (LQ>0){ int k=j*tws; w1=cmul(twA[k>>6],twB[k&63]); w2=cmul(w1,w1); w3=cmul(w2,w1); }
    _Pragma("unroll") for (int i=0;i<8;++i){ int base=base0+i*2048; bf4c<INV,(LQ==0)>(Z,base,base+q,base+2*q,base+3*q,w1,w2,w3); }
  }
  if (BARRIER) __syncthreads(); else asm volatile("s_waitcnt lgkmcnt(0)" ::: "memory");
}
__device__ __forceinline__ void fft_fwd_head(float2* Z, const float2* twA, const float2* twB, int tid){
  fft_pass<false,10>(Z,twA,twB,tid); fft_pass<false,8>(Z,twA,twB,tid); fft_pass<false,6,false>(Z,twA,twB,tid);
  fft_pass<false,4,false>(Z,twA,twB,tid); fft_pass<false,2,false>(Z,twA,twB,tid);
}
__device__ __forceinline__ void fft_inv_tail(float2* Z, const float2* twA, const float2* twB, int tid){
  fft_pass<true,2,false>(Z,twA,twB,tid); fft_pass<true,4,false>(Z,twA,twB,tid); fft_pass<true,6>(Z,twA,twB,tid);
  fft_pass<true,8>(Z,twA,twB,tid); fft_pass<true,10>(Z,twA,twB,tid);
}
HD void fwd12_padded(float2* Z, const float2* twA, const float2* twB, int t, float2 a0, float2 a1){
  float2 w1=cmul(twA[t>>6],twB[t&63]), w2=cmul(w1,w1), w3=cmul(w2,w1);
  Z[t]=make_float2(a0.x+a1.x,a0.y+a1.y);
  Z[t+4096]=cmul(make_float2(a0.x+a1.y,a0.y-a1.x),w1);
  Z[t+8192]=cmul(make_float2(a0.x-a1.x,a0.y-a1.y),w2);
  Z[t+12288]=cmul(make_float2(a0.x-a1.y,a0.y+a1.x),w3);
}
HD void inv12_half(const float2* Z, const float2* twA, const float2* twB, int t, float2& x0, float2& x1){
  float2 w1=cmul(twA[t>>6],twB[t&63]), w2=cmul(w1,w1), w3=cmul(w2,w1);
  float2 b0=Z[t], b1=cmulc(Z[t+4096],w1), b2=cmulc(Z[t+8192],w2), b3=cmulc(Z[t+12288],w3);
  float2 s02=make_float2(b0.x+b2.x,b0.y+b2.y), d02=make_float2(b0.x-b2.x,b0.y-b2.y);
  float2 s13=make_float2(b1.x+b3.x,b1.y+b3.y), d13=make_float2(b1.x-b3.x,b1.y-b3.y);
  x0=make_float2(s02.x+s13.x,s02.y+s13.y);
  x1=make_float2(d02.x-d13.y,d02.y+d13.x);
}
typedef _Float16 f16x2 __attribute__((ext_vector_type(2)));
__device__ __forceinline__ void fft_mid(float2* Z, const f16x2* Hp, int tid){
  _Pragma("unroll 8") for (int i=0;i<8;++i){ int base=(tid<<2)+i*2048;
    u32x4 hw=*(const u32x4*)(Hp+base);
    unsigned hw0=hw[0], hw1=hw[1], hw2=hw[2], hw3=hw[3];
    float2 a0=Z[base], a1=Z[base+1], a2=Z[base+2], a3=Z[base+3];
    float2 s02=make_float2(a0.x+a2.x,a0.y+a2.y), d02=make_float2(a0.x-a2.x,a0.y-a2.y);
    float2 s13=make_float2(a1.x+a3.x,a1.y+a3.y), d13=make_float2(a1.x-a3.x,a1.y-a3.y);
    float2 y0=make_float2(s02.x+s13.x,s02.y+s13.y), y2=make_float2(s02.x-s13.x,s02.y-s13.y);
    float2 y1=make_float2(d02.x+d13.y,d02.y-d13.x);
    float2 y3=make_float2(d02.x-d13.y,d02.y+d13.x);
    f16x2 h0=__builtin_bit_cast(f16x2,hw0), h1=__builtin_bit_cast(f16x2,hw1), h2=__builtin_bit_cast(f16x2,hw2), h3=__builtin_bit_cast(f16x2,hw3);
    float2 b0=cmul(y0,make_float2((float)h0[0],(float)h0[1])), b1=cmul(y1,make_float2((float)h1[0],(float)h1[1]));
    float2 b2=cmul(y2,make_float2((float)h2[0],(float)h2[1])), b3=cmul(y3,make_float2((float)h3[0],(float)h3[1]));
    float2 t02=make_float2(b0.x+b2.x,b0.y+b2.y), e02=make_float2(b0.x-b2.x,b0.y-b2.y);
    float2 t13=make_float2(b1.x+b3.x,b1.y+b3.y), e13=make_float2(b1.x-b3.x,b1.y-b3.y);
    Z[base]=make_float2(t02.x+t13.x,t02.y+t13.y); Z[base+2]=make_float2(t02.x-t13.x,t02.y-t13.y);
    Z[base+1]=make_float2(e02.x-e13.y,e02.y+e13.x);
    Z[base+3]=make_float2(e02.x+e13.y,e02.y-e13.x);
  }
  asm volatile("s_waitcnt lgkmcnt(0)" ::: "memory");
}

constexpr int BM=256, BK=64, HALF=128, HT=HALF*BK;
__device__ __forceinline__ int lds_byte(int r, int c) {
  int st=(r>>4)*2+(c>>5), rr=r&15, cc=c&31, ob=rr*64+cc*2;
  return st*1024 + (ob ^ (((ob>>9)&1)<<5));
}
__device__ __forceinline__ void stage_rc(int b, int&R, int&C) {
  int st=b/1024, sb=b%1024, swz=sb^(((sb>>9)&1)<<5);
  R=(st>>1)*16+swz/64; C=(st&1)*32+(swz%64)/2;
}
#define GK 1024
#define SA(b,h) (shm+((b)*2+(h))*HT)
#define SB(b,h) (shm+(4+(b)*2+(h))*HT)
#define STAGE(P,BASE,br,kt) do{const u16* _gb=(BASE)+((long)(br)*GK+(long)(kt)*BK); \
    __builtin_amdgcn_global_load_lds((const unsigned*)(_gb+soff0), \
      (__attribute__((address_space(3))) unsigned*)((__attribute__((address_space(3))) char*)(P)+gtid*16),16,0,0); \
    __builtin_amdgcn_global_load_lds((const unsigned*)(_gb+soff1), \
      (__attribute__((address_space(3))) unsigned*)((__attribute__((address_space(3))) char*)(P)+gtid*16+8192),16,0,0);}while(0)
#define LDA(dst,b,h) _Pragma("unroll") for(int m=0;m<4;++m) _Pragma("unroll") for(int k=0;k<2;++k) \
  dst[m][k]=*reinterpret_cast<const __attribute__((address_space(3))) bf16x8*>((__attribute__((address_space(3))) char*)SA(b,h)+lds_byte(wr*64+m*16+fr,k*32+fq*8))
#define LDB(dst,b,h) _Pragma("unroll") for(int n=0;n<2;++n) _Pragma("unroll") for(int k=0;k<2;++k) \
  dst[n][k]=*reinterpret_cast<const __attribute__((address_space(3))) bf16x8*>((__attribute__((address_space(3))) char*)SB(b,h)+lds_byte(wc*32+n*16+fr,k*32+fq*8))
#define MMA(ai,bj,At,Bt_) do{__builtin_amdgcn_s_setprio(1); \
  _Pragma("unroll") for(int m=0;m<4;++m) _Pragma("unroll") for(int n=0;n<2;++n) _Pragma("unroll") for(int k=0;k<2;++k) \
    acc[ai][bj][m][n]=__builtin_amdgcn_mfma_f32_16x16x32_bf16(At[m][k],Bt_[n][k],acc[ai][bj][m][n],0,0,0); \
  __builtin_amdgcn_s_setprio(0);}while(0)
#define WAIT_V(n) asm volatile("s_waitcnt vmcnt(" #n ")":::"memory")
#define WAIT_L(n) asm volatile("s_waitcnt lgkmcnt(" #n ")":::"memory")
#define BAR __builtin_amdgcn_s_barrier()
#define SCHED __builtin_amdgcn_sched_barrier(0)

__device__ __forceinline__ void gemm_core(const u16* __restrict__ A, const u16* __restrict__ Bt, int brow, int bcol,
                                          f32x4 (&acc)[2][2][4][2]) {
  __attribute__((address_space(3))) u16* shm = (__attribute__((address_space(3))) u16*)smem;
  int gtid=threadIdx.x; asm volatile("" : "+v"(gtid));
  int wid=gtid>>6,lane=gtid&63,wr=wid>>2,wc=wid&3,fr=lane&15,fq=lane>>4;
  _Pragma("unroll") for(int a=0;a<2;++a) _Pragma("unroll") for(int b=0;b<2;++b) _Pragma("unroll") for(int m=0;m<4;++m) _Pragma("unroll") for(int n=0;n<2;++n) acc[a][b][m][n]=f32x4{0.f,0.f,0.f,0.f};
  bf16x8 At[4][2],B0[2][2],B1[2][2];
  int soff0, soff1; { int _r,_c; stage_rc(gtid*16,_r,_c); soff0=_r*GK+_c; stage_rc(gtid*16+8192,_r,_c); soff1=_r*GK+_c; }
  constexpr int nt=GK/BK;
  STAGE(SB(0,0),Bt,bcol,0); STAGE(SA(0,0),A,brow,0);
  STAGE(SB(0,1),Bt,bcol+HALF,0); STAGE(SA(0,1),A,brow+HALF,0);
  if(wr==1)BAR;
  WAIT_V(4); BAR;
  STAGE(SB(1,0),Bt,bcol,1); STAGE(SA(1,0),A,brow,1); STAGE(SB(1,1),Bt,bcol+HALF,1);
  WAIT_V(6); BAR;
  for(int t=0;t<nt-2;t+=2){
    LDB(B0,0,0); SCHED; LDA(At,0,0); STAGE(SA(1,1),A,brow+HALF,t+1);
    WAIT_L(8); BAR; WAIT_L(0); MMA(0,0,At,B0); BAR; SCHED;
    LDB(B1,0,1); STAGE(SB(0,0),Bt,bcol,t+2);
    BAR; WAIT_L(0); MMA(0,1,At,B1); BAR;
    LDA(At,0,1); STAGE(SA(0,0),A,brow,t+2);
    BAR; WAIT_L(0); MMA(1,0,At,B0); BAR; SCHED;
    STAGE(SB(0,1),Bt,bcol+HALF,t+2);
    WAIT_V(6); BAR; MMA(1,1,At,B1); BAR;
    LDB(B0,1,0); SCHED; LDA(At,1,0); STAGE(SA(0,1),A,brow+HALF,t+2);
    WAIT_L(8); BAR; WAIT_L(0); MMA(0,0,At,B0); BAR; SCHED;
    LDB(B1,1,1); STAGE(SB(1,0),Bt,bcol,t+3);
    BAR; WAIT_L(0); MMA(0,1,At,B1); BAR;
    LDA(At,1,1); STAGE(SA(1,0),A,brow,t+3);
    BAR; WAIT_L(0); MMA(1,0,At,B0); BAR; SCHED;
    STAGE(SB(1,1),Bt,bcol+HALF,t+3);
    WAIT_V(6); BAR; MMA(1,1,At,B1); BAR;
  }
  { LDB(B0,0,0); LDA(At,0,0); STAGE(SA(1,1),A,brow+HALF,nt-1);
    BAR; WAIT_L(0); MMA(0,0,At,B0); BAR;
    LDB(B1,0,1); BAR; WAIT_L(0); MMA(0,1,At,B1); BAR;
    LDA(At,0,1); WAIT_V(4); BAR; WAIT_L(0); MMA(1,0,At,B0); MMA(1,1,At,B1); BAR; }
  { LDB(B0,1,0); LDA(At,1,0); WAIT_V(2); BAR; WAIT_L(0); MMA(0,0,At,B0); BAR;
    LDB(B1,1,1); WAIT_V(0); BAR; WAIT_L(0); MMA(0,1,At,B1); BAR;
    LDA(At,1,1); BAR; WAIT_L(0); MMA(1,0,At,B0); MMA(1,1,At,B1); BAR; }
  if(wr==0)BAR;
  SCHED;
}
#define EPI_BEGIN { int _t=threadIdx.x; asm volatile("" : "+v"(_t)); int _wid=_t>>6,_lane=_t&63,_wr=_wid>>2,_wc=_wid&3,_fr=_lane&15,_fq=_lane>>4; \
  _Pragma("unroll") for(int ai=0;ai<2;++ai) _Pragma("unroll") for(int bj=0;bj<2;++bj) _Pragma("unroll") for(int m=0;m<4;++m) _Pragma("unroll") for(int n=0;n<2;++n){ \
    int R0=ai*HALF+_wr*64+m*16+_fq*4, C0=bj*HALF+_wc*32+n*16+_fr; f32x4 v=acc[ai][bj][m][n]; (void)R0; (void)C0;
#define EPI_END asm volatile("":::"memory"); }}
#define EPIG_BEGIN { int _t=threadIdx.x; asm volatile("" : "+v"(_t)); int _wid=_t>>6,_lane=_t&63,_wr=_wid>>2,_wc=_wid&3,_fr=_lane&15,_fq=_lane>>4; \
  _Pragma("unroll") for(int ai=0;ai<2;++ai) _Pragma("unroll") for(int bj=0;bj<2;++bj){
#define EPIG_FOR _Pragma("unroll") for(int m=0;m<4;++m) _Pragma("unroll") for(int n=0;n<2;++n){ const int idx=m*2+n; int R0=ai*HALF+_wr*64+m*16+_fq*4, C0=bj*HALF+_wc*32+n*16+_fr; (void)idx; (void)R0; (void)C0;
#define EPIG_ENDFOR }
#define EPIG_END asm volatile("":::"memory"); }}

__device__ __forceinline__ int wperm(int np){ return np<4096 ? np : (np<10240 ? np+32 : (np<10272 ? 4096+(np-10240) : -1)); }
__device__ __forceinline__ void transpose_tile(const float* __restrict__ src, int ld_src, int kind, u16* __restrict__ dst, int n0, int k0, int tid){
  float* tile = (float*)smem;
  _Pragma("unroll") for (int i=0;i<2;++i){ int e=tid+512*i; int kk=e>>4, n4=(e&15)*4; int np=n0+n4;
    float4 v=make_float4(0.f,0.f,0.f,0.f);
    if (kind==0){ int ns=wperm(np);
      if (ns>=0) v=*(const float4*)(src+(size_t)(k0+kk)*ld_src+ns); }
    else v=*(const float4*)(src+(size_t)(k0+kk)*ld_src+np);
    *(float4*)(tile+kk*68+n4)=v; }
  __syncthreads();
  { int nn=tid>>3, k8=(tid&7)*8;
    u32x4 pk;
    pk[0]=pack2(tile[(k8+0)*68+nn],tile[(k8+1)*68+nn]); pk[1]=pack2(tile[(k8+2)*68+nn],tile[(k8+3)*68+nn]);
    pk[2]=pack2(tile[(k8+4)*68+nn],tile[(k8+5)*68+nn]); pk[3]=pack2(tile[(k8+6)*68+nn],tile[(k8+7)*68+nn]);
    *(u32x4*)(dst+(size_t)(n0+nn)*1024+k0+k8)=pk; }
  __syncthreads();
}

__device__ __forceinline__ void phase_prep(KP kp_){ asm volatile("" : "+s"(kp_)); const Params p=load_params(kp_);
  int ftid=threadIdx.x; asm volatile("" : "+v"(ftid));
  int tid=ftid, lane=tid&63, wid=tid>>6;
  char* ws=p.ws;
  for (int it=blockIdx.x; it<2624; it+=gridDim.x){
    { int nt_=it>>4, kt=it&15; transpose_tile(p.w_in,10272,0,(u16*)(ws+OFF_WTIN),nt_*64,kt*64,tid); }
    if (false) { int j=it-2624; int w=j>>8; int r=j&255; int nt_=r>>4, kt=r&15;
      const float* src = w==0?p.w_pa:(w==1?p.w_pb:p.w_out); size_t off = w==0?OFF_WTPA:(w==1?OFF_WTPB:OFF_WTOUT);
      transpose_tile(src,1024,1,(u16*)(ws+off),nt_*64,kt*64,tid); }
  }
  float* modv=(float*)(ws+OFF_MOD);
  for (int it=blockIdx.x; it<256; it+=gridDim.x){
    float acc[3][12];
    for(int a=0;a<3;++a)for(int j=0;j<12;++j)acc[a][j]=0.f;
    for (int r=0;r<2;++r){ int k=tid+512*r;
      float s0=siluf(p.c[k]), s1=siluf(p.c[1024+k]), s2=siluf(p.c_ctx[k]);
      const float4* wp=(const float4*)(p.w_mod+(size_t)k*3072+it*12);
      for(int q=0;q<3;++q){ float4 w=wp[q];
        acc[0][q*4+0]+=s0*w.x; acc[0][q*4+1]+=s0*w.y; acc[0][q*4+2]+=s0*w.z; acc[0][q*4+3]+=s0*w.w;
        acc[1][q*4+0]+=s1*w.x; acc[1][q*4+1]+=s1*w.y; acc[1][q*4+2]+=s1*w.z; acc[1][q*4+3]+=s1*w.w;
        acc[2][q*4+0]+=s2*w.x; acc[2][q*4+1]+=s2*w.y; acc[2][q*4+2]+=s2*w.z; acc[2][q*4+3]+=s2*w.w; } }
    float* red=(float*)smem;
    for(int a=0;a<3;++a)for(int j=0;j<12;++j){ float v=wave_sum(acc[a][j]); if(lane==0) red[wid*36+a*12+j]=v; }
    __syncthreads();
    if (tid<36){ float s=0; for(int w=0;w<8;++w)s+=red[w*36+tid]; int a=tid/12,j=tid%12; modv[a*3072+it*12+j]=s+p.b_mod[it*12+j]; }
    __syncthreads();
  }
}
__device__ __forceinline__ void phase_side(KP kp_, int bid, int nb){ asm volatile("" : "+s"(kp_)); const Params p=load_params(kp_);
  int ftid=threadIdx.x; asm volatile("" : "+v"(ftid));
  int tid=ftid, lane=tid&63, wid=tid>>6;
  char* ws=p.ws;
  for (int j=bid; j<768; j+=nb){ int w=j>>8; int r=j&255; int nt_=r>>4, kt=r&15;
    const float* src = w==0?p.w_pa:(w==1?p.w_pb:p.w_out); size_t off = w==0?OFF_WTPA:(w==1?OFF_WTPB:OFF_WTOUT);
    transpose_tile(src,1024,1,(u16*)(ws+off),nt_*64,kt*64,tid); }
  _Float16* a3=(_Float16*)(ws+OFF_A3);
  for (int t=bid*8+wid; t<8192; t+=nb*8){
    float pe=0.f;
    if (lane==0) pe=(float)t/8191.f;
    else if (lane<33){ int bi=(lane-1)&15; float s=(float)bi/15.f; float fb=1e-4f*(1.f-s)+15.f*s; float wpos=(float)(6.283185307179586/8192.0)*(float)t; float arg=fb*wpos;
      pe = lane<17 ? cosf(arg) : -sinf(arg); }
    float fr_=p.f_freq[lane];
    float acc=p.f_b1[lane];
    for(int i=0;i<33;++i) acc += __shfl(pe,i)*p.f_w1[i*64+lane];
    float a1=sinf(fr_*acc);
    acc=p.f_b2[lane];
    for(int i=0;i<64;++i) acc += __shfl(a1,i)*p.f_w2[i*64+lane];
    float a2=sinf(fr_*acc);
    acc=p.f_b3[lane];
    for(int i=0;i<64;++i) acc += __shfl(a2,i)*p.f_w3[i*64+lane];
    a3[t*64+lane]=(_Float16)sinf(fr_*acc);
  }
  float2* tw=(float2*)(ws+OFF_TW);
  for (int k=bid*512+tid; k<16384; k+=nb*512){
    float s,c; sincospif((float)k/8192.f,&s,&c); tw[k]=make_float2(c,-s); }
}

__device__ __forceinline__ void phase_h(KP kp_){ asm volatile("" : "+s"(kp_)); const Params p=load_params(kp_);
  int ftid=threadIdx.x; asm volatile("" : "+v"(ftid));
  int lane=ftid&63, wid=ftid>>6;
  const float* modv=(const float*)(p.ws+OFF_MOD);
  u16* hbuf=(u16*)(p.ws+OFF_HBUF);
  for (int r=blockIdx.x*8+wid; r<16896; r+=gridDim.x*8){
    const float* src = r<16384 ? p.x+(size_t)r*1024 : p.ctx+(size_t)(r-16384)*1024;
    int v = r<16384 ? (r>>13) : 2;
    float4 xv[4]; float ss=0.f;
    for(int i=0;i<4;++i){ xv[i]=*(const float4*)(src+lane*4+256*i); ss+=xv[i].x*xv[i].x+xv[i].y*xv[i].y+xv[i].z*xv[i].z+xv[i].w*xv[i].w; }
    ss=wave_sum(ss); float rstd=rsqrtf(ss*(1.f/1024.f)+EPSV);
    for(int i=0;i<4;++i){ int col=lane*4+256*i;
      float4 g=*(const float4*)(p.norm_g+col); float4 sh=*(const float4*)(modv+v*3072+col); float4 sc=*(const float4*)(modv+v*3072+1024+col);
      float h0=xv[i].x*rstd*g.x*(1.f+sc.x)+sh.x, h1=xv[i].y*rstd*g.y*(1.f+sc.y)+sh.y, h2=xv[i].z*rstd*g.z*(1.f+sc.z)+sh.z, h3=xv[i].w*rstd*g.w*(1.f+sc.w)+sh.w;
      uint2 pk; pk.x=pack2(h0,h1); pk.y=pack2(h2,h3);
      *(uint2*)(hbuf+(size_t)r*1024+col)=pk; }
  }
}

__device__ __forceinline__ void phase_gemm_hy(KP kp_, int hf){ asm volatile("" : "+s"(kp_)); const Params p=load_params(kp_);
  const u16* hbuf=(const u16*)(p.ws+OFF_HBUF); const u16* wt=(const u16*)(p.ws+OFF_WTIN); u16* phyT=(u16*)(p.ws+OFF_PHYT); u16* PG=(u16*)p.out;
  int ntile = hf==0 ? 1024 : 512;
  for (int it=blockIdx.x; it<ntile; it+=gridDim.x){
    f32x4 acc[2][2][4][2];
    if (it<512){
      int q8=it&7, rt=it>>3; int g=q8>>1, tt=q8&1; int ct=16+g*4+hf*2+tt;
      gemm_core(hbuf, wt, rt*256, ct*256, acc);
      EPI_BEGIN
        int tok=rt*256+R0; int prow=g*512+tt*256+C0;
        if (g==3){ v[0]=siluf(v[0]); v[1]=siluf(v[1]); v[2]=siluf(v[2]); v[3]=siluf(v[3]); }
        uint2 pk; pk.x=pack2(v[0],v[1]); pk.y=pack2(v[2],v[3]);
        *(uint2*)(phyT+(size_t)prow*16384+tok)=pk;
      EPI_END
    } else {
      int j=it-512; int ct=32+(j&7), rt=j>>3;
      gemm_core(wt, hbuf, ct*256, rt*256, acc);
      EPI_BEGIN
        int np=ct*256+R0; int tok=rt*256+C0;
        uint2 pk; pk.x=pack2(sigmf(v[0]),sigmf(v[1])); pk.y=pack2(sigmf(v[2]),sigmf(v[3])); *(uint2*)(PG+(size_t)tok*2048+(np-8192))=pk;
      EPI_END
    }
  }
}

__device__ __forceinline__ float hconv3(const u16* __restrict__ row, int t, float w0, float w1, float w2, float bias){
  float m = bf2f(row[t]);
  int mi=__float_as_int(m);
  float l=__int_as_float(__builtin_amdgcn_update_dpp(0, mi, 0x138, 0xf, 0xf, false));
  float r=__int_as_float(__builtin_amdgcn_update_dpp(0, mi, 0x130, 0xf, 0xf, false));
  return w0*l+w1*m+w2*r+bias;
}
typedef _Float16 f16x8 __attribute__((ext_vector_type(8)));
__device__ __forceinline__ float2 ld_h2_coherent(const f16x2* ptr){
  unsigned u = __hip_atomic_load((const unsigned*)ptr, __ATOMIC_RELAXED, __HIP_MEMORY_SCOPE_AGENT);
  f16x2 h=__builtin_bit_cast(f16x2,u); return make_float2((float)h[0],(float)h[1]);
}
__device__ __forceinline__ void phase_hyena(KP kp_, int hf){ asm volatile("" : "+s"(kp_)); const Params p=load_params(kp_);
  int ftid=threadIdx.x; asm volatile("" : "+v"(ftid));
  int tid=ftid, lane=tid&63, wid=tid>>6;
  float2* Z=(float2*)smem; float* misc=(float*)(smem+131072);
  float2* twA=(float2*)(misc+512); float2* twB=(float2*)(misc+640);
  const float2* tw=(const float2*)(p.ws+OFF_TW);
  const _Float16* a3=(const _Float16*)(p.ws+OFF_A3);
  const u16* phyT=(const u16*)(p.ws+OFF_PHYT);
  u16* ybT=(u16*)(p.ws+OFF_YBT);
  char* scr=p.ws+OFF_FS+(size_t)blockIdx.x*196608;
  f16x2* H0p=(f16x2*)scr; f16x2* H1p=H0p+16384; float2* Zs=(float2*)(scr+131072);
  if (tid<64) twA[tid]=tw[tid*64]; else if (tid<128) twB[tid-64]=tw[tid-64];
  for (int cl=blockIdx.x; cl<512; cl+=gridDim.x){ int c=hf*512+cl;
    asm volatile("" : "+v"(tid)); lane=tid&63; wid=tid>>6;
    __syncthreads();
    if (tid<256){ int i=tid>>2, so=tid&3; misc[tid]=p.f_wout[(size_t)i*4096+(so>>1)*2048+(so&1)*1024+c]; }
    __syncthreads();
    const float lo=-3.0701134573253945f, hi=-15.350567286626973f;
    float sfrac=(float)c/1023.f;
    float delta=fabsf(lo*(1.f-sfrac)+hi*sfrac);
    const u16* rv=phyT+(size_t)cl*16384; const u16* r1=phyT+(size_t)(512+cl)*16384; const u16* r2=phyT+(size_t)(1024+cl)*16384; const u16* rz=phyT+(size_t)(1536+cl)*16384;
    float wv0=p.hy_conv_w[c], wv1=p.hy_conv_w[3072+c], wv2=p.hy_conv_w[6144+c], bv_=p.hy_conv_b[c];
    float wa0=p.hy_conv_w[1024+c], wa1=p.hy_conv_w[3072+1024+c], wa2=p.hy_conv_w[6144+1024+c], ba_=p.hy_conv_b[1024+c];
    float wb0=p.hy_conv_w[2048+c], wb1=p.hy_conv_w[3072+2048+c], wb2=p.hy_conv_w[6144+2048+c], bb_=p.hy_conv_b[2048+c];
    float bias0=p.hy_bias[c], bias1=p.hy_bias[1024+c];
    float nrm0=1.f, nrm1=1.f;
    _Pragma("unroll 1") for (int st=0; st<3; ++st){
      if (st==0){
    float ss0=0.f, ss1=0.f;
    {
      int n=lane&15, kg=lane>>4;
      f16x8 bw0, bw1;
      _Pragma("unroll") for (int e=0;e<8;++e){ bw0[e]=(n<4)?(_Float16)misc[(kg*8+e)*4+n]:(_Float16)0.f; bw1[e]=(n<4)?(_Float16)misc[(32+kg*8+e)*4+n]:(_Float16)0.f; }
      const float dsc=-delta*(1.f/8191.f);
      float pj0=__expf(dsc*(float)(kg*4)), pj1=__expf(dsc*(float)(kg*4+1)), pj2=__expf(dsc*(float)(kg*4+2)), pj3=__expf(dsc*(float)(kg*4+3));
      float* Zf=(float*)Z; float ssl=0.f; int order=n&1; bool side1=(n&2)!=0;
      _Pragma("unroll 8") for (int i=0;i<64;++i){ int tl=wid+8*i;
        const _Float16* ap=a3+(size_t)(tl*16+n)*64+kg*8;
        f16x8 a0=*(const f16x8*)ap, a1=*(const f16x8*)(ap+32);
        f32x4 dd={0.f,0.f,0.f,0.f};
        dd=__builtin_amdgcn_mfma_f32_16x16x32_f16(a0,bw0,dd,0,0,0);
        dd=__builtin_amdgcn_mfma_f32_16x16x32_f16(a1,bw1,dd,0,0,0);
        if (n<4){ float d0=__expf(dsc*(float)(tl*16)); int lag0=tl*16+kg*4;
          float v0=dd[0]*d0*pj0, v1=dd[1]*d0*pj1, v2=dd[2]*d0*pj2, v3=dd[3]*d0*pj3;
          if (!side1){ Zf[2*(lag0)+order]=v0; Zf[2*(lag0+1)+order]=v1; Zf[2*(lag0+2)+order]=v2; Zf[2*(lag0+3)+order]=v3; ssl+=v0*v0+v1*v1+v2*v2+v3*v3; }
          else { if (lag0>=1){ Zf[2*(16384-lag0)+order]=v0; ssl+=v0*v0; }
            Zf[2*(16384-lag0-1)+order]=v1; Zf[2*(16384-lag0-2)+order]=v2; Zf[2*(16384-lag0-3)+order]=v3; ssl+=v1*v1+v2*v2+v3*v3; } }
      }
      ss0=(n<4 && order==0)?ssl:0.f; ss1=(n<4 && order==1)?ssl:0.f;
    }
    if (tid==0) Z[8192]=make_float2(0.f,0.f);
    ss0=wave_sum(ss0); ss1=wave_sum(ss1);
    if (lane==0){ misc[256+wid*2]=ss0; misc[256+wid*2+1]=ss1; }
    __syncthreads();
    float t0=0.f,t1=0.f; for(int w=0;w<8;++w){ t0+=misc[256+w*2]; t1+=misc[256+w*2+1]; }
    nrm0=rsqrtf(t0+EPSV); nrm1=rsqrtf(t1+EPSV);
      }
      __syncthreads();
      if (st==0){ fft_pass<false,12>(Z,twA,twB,tid); }
      else if (st==1){ int tq=tid; asm volatile("" : "+v"(tq));
        _Pragma("unroll 4") for (int i=0;i<8;++i){ int t=tq+512*i;
          float2 a0=make_float2(hconv3(rv,t,wv0,wv1,wv2,bv_), hconv3(rv+8192,t,wv0,wv1,wv2,bv_));
          float2 a1=make_float2(hconv3(rv,t+4096,wv0,wv1,wv2,bv_), hconv3(rv+8192,t+4096,wv0,wv1,wv2,bv_));
          fwd12_padded(Z,twA,twB,t,a0,a1); }
        __syncthreads();
      } else { int tq=tid; asm volatile("" : "+v"(tq));
        _Pragma("unroll 4") for (int i=0;i<8;++i){ int t=tq+512*i; fwd12_padded(Z,twA,twB,t,Zs[t],Zs[t+4096]); }
        __syncthreads();
      }
      fft_fwd_head(Z,twA,twB,tid);
      if (st==0){
        fft_pass<false,0>(Z,twA,twB,tid);
    _Pragma("unroll 2") for (int i=0;i<8;++i){ int q0=(tid+512*i)*4; u32x4 h0w, h1w;
      _Pragma("unroll") for (int m=0;m<4;++m){ int q=q0+m; int k=rev4_14(q);
        float2 Fk=Z[q], Fn=Z[rev4_14((16384-k)&16383)];
        f16x2 h0v={(_Float16)(0.5f*nrm0*(Fk.x+Fn.x)),(_Float16)(0.5f*nrm0*(Fk.y-Fn.y))};
        f16x2 h1v={(_Float16)(0.5f*nrm1*(Fk.y+Fn.y)),(_Float16)(-0.5f*nrm1*(Fk.x-Fn.x))};
        unsigned u0=__builtin_bit_cast(unsigned,h0v), u1=__builtin_bit_cast(unsigned,h1v);
        h0w[m]=u0; h1w[m]=u1; }
      *(u32x4*)(H0p+q0)=h0w; *(u32x4*)(H1p+q0)=h1w; }
        __builtin_amdgcn_fence(__ATOMIC_ACQUIRE, "agent");
      } else {
        const f16x2* Hp = st==1 ? H0p : H1p;
        fft_mid(Z,Hp,tid);
        fft_inv_tail(Z,twA,twB,tid);
        if (st==1){ int tq=tid; asm volatile("" : "+v"(tq));
          _Pragma("unroll 4") for (int i=0;i<8;++i){ int tb=tq+512*i; float2 xr[2]; inv12_half(Z,twA,twB,tb,xr[0],xr[1]);
            _Pragma("unroll") for (int hh=0;hh<2;++hh){ int t=tb+hh*4096;
              float u0=hconv3(rv,t,wv0,wv1,wv2,bv_), u1=hconv3(rv+8192,t,wv0,wv1,wv2,bv_);
              float x0=hconv3(r1,t,wa0,wa1,wa2,ba_), x1=hconv3(r1+8192,t,wa0,wa1,wa2,ba_);
              float2 y=xr[hh]; y.x*=(1.f/16384.f); y.y*=(1.f/16384.f);
              Zs[t]=make_float2(x0*(y.x+u0*bias0), x1*(y.y+u1*bias0)); } }
        } else { int tq=tid; asm volatile("" : "+v"(tq));
          _Pragma("unroll 4") for (int i=0;i<8;++i){ int tb=tq+512*i; float2 xr[2]; inv12_half(Z,twA,twB,tb,xr[0],xr[1]);
            _Pragma("unroll") for (int hh=0;hh<2;++hh){ int t=tb+hh*4096;
              float x0=hconv3(r2,t,wb0,wb1,wb2,bb_), x1=hconv3(r2+8192,t,wb0,wb1,wb2,bb_);
              float2 y=xr[hh]; y.x*=(1.f/16384.f); y.y*=(1.f/16384.f); float2 z1=Zs[t];
              float o0=x0*(y.x+z1.x*bias1)*bf2f(rz[t]); float o1=x1*(y.y+z1.y*bias1)*bf2f(rz[8192+t]);
              ybT[(size_t)c*16384+t]=f2bf(o0); ybT[(size_t)c*16384+8192+t]=f2bf(o1); } }
        }
      }
      __syncthreads();
    }
  }
}

__device__ __forceinline__ void phase_ybt(KP kp_){ asm volatile("" : "+s"(kp_)); const Params p=load_params(kp_);
  int tid=threadIdx.x; asm volatile("" : "+v"(tid));
  const u16* ybT=(const u16*)(p.ws+OFF_YBT); u16* yb=(u16*)(p.ws+OFF_YB);
  u16* tile=(u16*)smem;
  for (int it=blockIdx.x; it<4096; it+=gridDim.x){
    int c0=(it&15)*64, t0=(it>>4)*64;
    __syncthreads();
    { int ch=tid>>3, t8=(tid&7)*8; *(u32x4*)(tile+ch*72+t8)=*(const u32x4*)(ybT+(size_t)(c0+ch)*16384+t0+t8); }
    __syncthreads();
    { int tk=tid>>3, c8=(tid&7)*8; u32x4 pk;
      _Pragma("unroll") for (int q=0;q<4;++q) pk[q]=(unsigned)tile[(c8+2*q)*72+tk] | ((unsigned)tile[(c8+2*q+1)*72+tk]<<16);
      *(u32x4*)(yb+(size_t)(t0+tk)*1024+c0+c8)=pk; }
  }
}

__device__ __forceinline__ void phase_gemm_dn(KP kp_){ asm volatile("" : "+s"(kp_)); const Params p=load_params(kp_);
  const u16* hbuf=(const u16*)(p.ws+OFF_HBUF); const u16* wt=(const u16*)(p.ws+OFF_WTIN);
  u16* R1=(u16*)(p.ws+OFF_R1); u16* ZA=(u16*)(p.ws+OFF_ZA); float* gates=(float*)(p.ws+OFF_GATES);
  for (int it=blockIdx.x; it<1056+66; it+=gridDim.x){
    int ct, rt;
    if (it<1056){ ct=it&15; rt=it>>4; } else { ct=40; rt=it-1056; }
    f32x4 acc[2][2][4][2];
    gemm_core(wt, hbuf, ct*256, rt*256, acc);
    EPI_BEGIN
      int np=ct*256+R0; int tok=rt*256+C0;
      if (ct<12){ uint2 pk; pk.x=pack2(v[0],v[1]); pk.y=pack2(v[2],v[3]); *(uint2*)(R1+(size_t)tok*3072+np)=pk; }
      else if (ct<16){ if (tok<16384){ uint2 pk; pk.x=pack2(siluf(v[0]),siluf(v[1])); pk.y=pack2(siluf(v[2]),siluf(v[3])); *(uint2*)(ZA+(size_t)tok*1024+(np-3072))=pk; } }
      else { int g=np-10240; if (g<32){ *(float4*)(gates+(size_t)tok*32+g)=make_float4(v[0],v[1],v[2],v[3]); } }
    EPI_END
  }
}

__device__ __forceinline__ void slot_bases(char* ws, int b, int cidx, int h, char*& bq, char*& bk, char*& bv, int& stride){
  if (cidx>=4){ int n=cidx-4; size_t tok0=(size_t)b*8192+n*64; char* base=ws+OFF_R1+tok0*6144+(size_t)h*256; bq=base; bk=base+2048; bv=base+4096; stride=6144; }
  else { char* base=ws+OFF_R1C+(size_t)((b*4+cidx)*8+h)*49152; bq=base; bk=base+16384; bv=base+32768; stride=256; }
}
__device__ __forceinline__ void phase_dnprep(KP kp_){ asm volatile("" : "+s"(kp_)); const Params p=load_params(kp_);
  float* raw=(float*)smem;
  float* tmp=(float*)(smem+34816);
  char* qs=smem+67584;
  char* ks=smem+84992;
  float* Lf=(float*)(smem+102400);
  float* Lb=(float*)(smem+118784);
  float* sm=(float*)(smem+135168);
  float *gcf=sm, *gcb=sm+64, *bef=sm+128, *beb=sm+192, *scl=sm+256;
  const u16* R1=(const u16*)(p.ws+OFF_R1); const float* gates=(const float*)(p.ws+OFF_GATES);
  u32x4 rp0,rp1,rp2; bool have_raw=false;
  for (int item=blockIdx.x; item<2112; item+=gridDim.x){
    int tid=threadIdx.x; asm volatile("" : "+v"(tid)); int lane=tid&63, wid=tid>>6;
    int b,n,h,cidx,tok0,rs,re;
    if (item<2048){ b=item>>10; n=(item>>3)&127; h=item&7; cidx=n+4; tok0=b*8192+n*64; rs=tok0; re=tok0+64; }
    else { int j=item-2048; b=j>>5; n=(j>>3)&3; h=j&7; cidx=n; tok0=16384+b*256+n*64; rs=16384+b*256; re=rs+256; }
    char *bq,*bk,*bv; int stride; slot_bases(p.ws,b,cidx,h,bq,bk,bv,stride);
    size_t ia=(size_t)((b*8+h)*132+cidx)*TA_STRIDE;
    char* taf=(char*)p.out+ia; char* tab=p.ws+OFF_TAB+ia;
    __syncthreads();
    if (wid==0){ const float* gr=gates+(size_t)(tok0+lane)*32;
      float bf_=1.f/(1.f+expf(-gr[h])), bb_=1.f/(1.f+expf(-gr[8+h]));
      float xf=gr[16+h]+p.dn_dt_bias[h], xb=gr[24+h]+p.dn_dt_bias[8+h];
      float spf=xf>20.f?xf:log1pf(expf(xf)), spb=xb>20.f?xb:log1pf(expf(xb));
      float gf=-expf(p.dn_a_log[h])*spf, gb=-expf(p.dn_a_log[8+h])*spb;
      for (int o=1;o<64;o<<=1){ float t=__shfl_up(gf,o); if (lane>=o) gf+=t; float u=__shfl_down(gb,o); if (lane+o<64) gb+=u; }
      gcf[lane]=gf; gcb[lane]=gb; bef[lane]=bf_; beb[lane]=bb_;
      *(float*)(taf+24576+lane*4)=gf; *(float*)(tab+24576+lane*4)=gb; }
#define RAWLOAD_AT(w_,tok0,rs,re,h) { const u16* rb=R1+(size_t)(w_)*1024+(h)*128; \
      { int e=tid; int i=e>>4, c8=(e&15)*8; int tk=tok0-2+i; rp0=u32x4{0,0,0,0}; if (tk>=rs && tk<re) rp0=*(const u32x4*)(rb+(size_t)tk*3072+c8); } \
      { int e=tid+512; int i=e>>4, c8=(e&15)*8; int tk=tok0-2+i; rp1=u32x4{0,0,0,0}; if (tk>=rs && tk<re) rp1=*(const u32x4*)(rb+(size_t)tk*3072+c8); } \
      { int e=tid+1024; int i=e>>4, c8=(e&15)*8; int tk=tok0-2+i; rp2=u32x4{0,0,0,0}; if (e<1088 && tk>=rs && tk<re) rp2=*(const u32x4*)(rb+(size_t)tk*3072+c8); } }
#define RAWPUT1(rp_,e_) { int e=(e_); if (e<1088){ int i=e>>4, c8=(e&15)*8; float* d=raw+i*128+c8; \
      d[0]=__uint_as_float(rp_[0]<<16); d[1]=__uint_as_float(rp_[0]&0xffff0000u); d[2]=__uint_as_float(rp_[1]<<16); d[3]=__uint_as_float(rp_[1]&0xffff0000u); \
      d[4]=__uint_as_float(rp_[2]<<16); d[5]=__uint_as_float(rp_[2]&0xffff0000u); d[6]=__uint_as_float(rp_[3]<<16); d[7]=__uint_as_float(rp_[3]&0xffff0000u); } }
#define RAWLOAD(w_) RAWLOAD_AT(w_,tok0,rs,re,h)
#define ITEM_DECODE(it_,b_,n_,h_,cidx_,tok0_,rs_,re_) { if ((it_)<2048){ b_=(it_)>>10; n_=((it_)>>3)&127; h_=(it_)&7; cidx_=n_+4; tok0_=b_*8192+n_*64; rs_=tok0_; re_=tok0_+64; } \
      else { int j_=(it_)-2048; b_=j_>>5; n_=(j_>>3)&3; h_=j_&7; cidx_=n_; tok0_=16384+b_*256+n_*64; rs_=16384+b_*256; re_=rs_+256; } }
    if (!have_raw) RAWLOAD(0);
    _Pragma("unroll 1") for (int which=0; which<3; ++which){
      asm volatile("" : "+v"(tid));
      RAWPUT1(rp0,tid); RAWPUT1(rp1,tid+512); RAWPUT1(rp2,tid+1024);
      if (which<2) RAWLOAD(which+1);
      __syncthreads();
      int c=tid&127, tg=tid>>7; int ch=which*1024+h*128+c;
      float w0=p.dn_conv_w[ch], w1=p.dn_conv_w[3072+ch], w2=p.dn_conv_w[6144+ch], w3=p.dn_conv_w[9216+ch], w4=p.dn_conv_w[12288+ch];
      float o16[16];
      { float rw[20];
        _Pragma("unroll") for (int i=0;i<20;++i) rw[i]=raw[(tg*16+i)*128+c];
        _Pragma("unroll") for (int i=0;i<16;++i){
          float a=w0*rw[i]+w1*rw[i+1]+w2*rw[i+2]+w3*rw[i+3]+w4*rw[i+4];
          o16[i]=a/(1.f+__expf(-a)); } }
      if (which==2){
        char* dst=bv+(size_t)(c>>1)*stride+(c&1)*128+tg*32;
        uint4 p0, p1;
        p0.x=pack2(o16[0],o16[1]); p0.y=pack2(o16[2],o16[3]); p0.z=pack2(o16[4],o16[5]); p0.w=pack2(o16[6],o16[7]);
        p1.x=pack2(o16[8],o16[9]); p1.y=pack2(o16[10],o16[11]); p1.z=pack2(o16[12],o16[13]); p1.w=pack2(o16[14],o16[15]);
        *(uint4*)dst=p0; *(uint4*)(dst+16)=p1;
      } else {
        _Pragma("unroll") for (int i=0;i<16;++i) tmp[(tg*16+i)*128+c]=o16[i];
        __syncthreads();
        { int t=tid>>3, c0=(tid&7)*16; float ss=0.f;
          _Pragma("unroll") for(int cc=0;cc<16;++cc){ float s_=tmp[t*128+c0+cc]; ss+=s_*s_; }
          ss+=__shfl_xor(ss,1); ss+=__shfl_xor(ss,2); ss+=__shfl_xor(ss,4);
          if ((tid&7)==0) scl[t]=rsqrtf(ss+EPSV)*(which==0?0.08838834764831845f:1.f); }
        __syncthreads();
        char* sdst= which==0?qs:ks;
        _Pragma("unroll") for (int i=0;i<16;++i){ o16[i]*=scl[tg*16+i]; *(u16*)(sdst+(tg*16+i)*272+c*2)=f2bf(o16[i]); }
        if (which==0){ _Pragma("unroll") for (int i=0;i<16;++i) *(u16*)(bq+(size_t)(tg*16+i)*stride+c*2)=f2bf(o16[i]); }
        else { char* dst=bk+(size_t)(c>>1)*stride+(c&1)*128+tg*32;
          uint4 p0, p1;
          p0.x=pack2(o16[0],o16[1]); p0.y=pack2(o16[2],o16[3]); p0.z=pack2(o16[4],o16[5]); p0.w=pack2(o16[6],o16[7]);
          p1.x=pack2(o16[8],o16[9]); p1.y=pack2(o16[10],o16[11]); p1.z=pack2(o16[12],o16[13]); p1.w=pack2(o16[14],o16[15]);
          *(uint4*)dst=p0; *(uint4*)(dst+16)=p1; }
      }
      __syncthreads();
    }
    { int nx=item+gridDim.x; have_raw=false;
      if (nx<2112){ int b2,n2,h2,c2,t2,rs2,re2; ITEM_DECODE(nx,b2,n2,h2,c2,t2,rs2,re2); (void)c2; RAWLOAD_AT(0,t2,rs2,re2,h2); have_raw=true; } }
    { int r=lane&15, kg=lane>>4;
      for (int tt=0; tt<2; ++tt){ int t=wid*2+tt; int mt=t>>2, nt=t&3;
        f32x4 akk={0.f,0.f,0.f,0.f}, aqk={0.f,0.f,0.f,0.f};
        _Pragma("unroll") for (int k4=0;k4<4;++k4){
          bf16x8 Bk=*(const bf16x8*)(ks+(nt*16+r)*272+(k4*32+kg*8)*2);
          bf16x8 Ak=*(const bf16x8*)(ks+(mt*16+r)*272+(k4*32+kg*8)*2);
          bf16x8 Aq=*(const bf16x8*)(qs+(mt*16+r)*272+(k4*32+kg*8)*2);
          akk=__builtin_amdgcn_mfma_f32_16x16x32_bf16(Ak,Bk,akk,0,0,0);
          aqk=__builtin_amdgcn_mfma_f32_16x16x32_bf16(Aq,Bk,aqk,0,0,0); }
        int jj=nt*16+r; float gfj=gcf[jj], gbj=gcb[jj];
        _Pragma("unroll") for (int j=0;j<4;++j){ int i=mt*16+kg*4+j;
          float ef=__expf(fminf(gcf[i]-gfj,0.f)), eb=__expf(fminf(gcb[i]-gbj,0.f));
          float lf=(jj<i)?bef[i]*akk[j]*ef:0.f;
          float af=(jj<=i)?aqk[j]*ef:0.f;
          float lb=(jj>i)?beb[i]*akk[j]*eb:0.f;
          float ab=(jj>=i)?aqk[j]*eb:0.f;
          Lf[i*64+jj]=lf; Lb[(63-i)*64+(63-jj)]=lb;
          *(u16*)(taf+16384+(i*64+jj)*2)=f2bf(af); *(u16*)(tab+16384+(i*64+jj)*2)=f2bf(ab); }
      } }
    __syncthreads();
    if (wid<2){
      int lbase = wid==0 ? 102400 : 118784; asm volatile("" : "+v"(lbase));
      float Tc[64];
      float4 lcur[16], lnxt[16];
      _Pragma("unroll") for (int r4=0;r4<16;++r4){ lcur[r4]=make_float4(0.f,0.f,0.f,0.f); lnxt[r4]=lcur[r4]; }
      _Pragma("unroll") for (int r=0;r<64;++r){
        if (r+1<64){ _Pragma("unroll") for (int r4=0;r4<(r+1+3)/4;++r4) lnxt[r4]=*(const float4*)(smem+lbase+((r+1)*64+r4*4)*4); }
        float a0=(r==lane)?1.f:0.f, a1=0.f, a2=0.f, a3=0.f;
        _Pragma("unroll") for (int r4=0;r4<(r+3)/4;++r4){ float4 l=lcur[r4];
          if (r4*4+0<r) a0-=l.x*Tc[r4*4+0]; if (r4*4+1<r) a1-=l.y*Tc[r4*4+1]; if (r4*4+2<r) a2-=l.z*Tc[r4*4+2]; if (r4*4+3<r) a3-=l.w*Tc[r4*4+3]; }
        Tc[r]=(a0+a1)+(a2+a3);
        _Pragma("unroll") for (int r4=0;r4<16;++r4) lcur[r4]=lnxt[r4];
        asm volatile("":::"memory"); }
      if (wid==0){ int c=lane; float su=bef[c], sw=su*__expf(gcf[c]);
        _Pragma("unroll") for (int r=0;r<64;++r){ *(u16*)(taf+(r*64+c)*2)=f2bf(Tc[r]*sw); *(u16*)(taf+8192+(r*64+c)*2)=f2bf(Tc[r]*su); } }
      else { int j=63-lane; float su=beb[j], sw=su*__expf(gcb[j]);
        _Pragma("unroll") for (int r=0;r<64;++r){ int i=63-r; *(u16*)(tab+(i*64+j)*2)=f2bf(Tc[r]*sw); *(u16*)(tab+8192+(i*64+j)*2)=f2bf(Tc[r]*su); } }
    }
  }
}

#define SQ 0
#define SKT 17408
#define SVT 35840
#define STW 54272
#define STU 63488
#define SAT 72704
#define SGC 81920
#define SWB 82176
__device__ __forceinline__ bf16x8 lds128(int off){ return *(const bf16x8*)(smem+off); }
__device__ __forceinline__ bf16x8 lds64x2(int off){ uint2 a=*(const uint2*)(smem+off), b=*(const uint2*)(smem+off+32); u32x4 t={a.x,a.y,b.x,b.y}; return __builtin_bit_cast(bf16x8,t); }
__device__ __forceinline__ bf16x8 packfrag(f32x4 d0, f32x4 d1){ u32x4 t={pack2(d0[0],d0[1]),pack2(d0[2],d0[3]),pack2(d1[0],d1[1]),pack2(d1[2],d1[3])}; return __builtin_bit_cast(bf16x8,t); }
#define MF(a,b,c) __builtin_amdgcn_mfma_f32_16x16x32_bf16(a,b,c,0,0,0)
__device__ __forceinline__ void phase_scan(KP kp_){ asm volatile("" : "+s"(kp_)); const Params p=load_params(kp_);
  int ftid=threadIdx.x; asm volatile("" : "+v"(ftid));
  int tid=ftid, lane=tid&63, wv=tid>>6, r=lane&15, kg=lane>>4;
  for (int item=blockIdx.x; item<32; item+=gridDim.x){
    int d=item&1, h=(item>>1)&7, b=item>>4;
    char* tabase = d ? (p.ws+OFF_TAB) : (char*)p.out;
    f32x4 Sacc[8];
    _Pragma("unroll") for (int i=0;i<8;++i) Sacc[i]=f32x4{0.f,0.f,0.f,0.f};
    u32x4 pq0A,pq1A,pk0A,pk1A,pv0A,pv1A,pt0A,pt1A,pt2A; float pgA;
    u32x4 pq0B,pq1B,pk0B,pk1B,pv0B,pv1B,pt0B,pt1B,pt2B; float pgB;
#define PREFETCH(X,s_) { int s__=(s_); int cidx=s__<4?(d?3-s__:s__):4+(d?131-s__:s__-4); char *bq,*bk,*bv; int stride; slot_bases(p.ws,b,cidx,h,bq,bk,bv,stride); \
      const char* ta=tabase+(size_t)((b*8+h)*132+cidx)*TA_STRIDE; \
      { int e=tid; pq0##X=*(const u32x4*)(bq+(size_t)(e>>4)*stride+(e&15)*16); int row=e>>3; size_t ko=(size_t)(row>>1)*stride+(row&1)*128+(e&7)*16; pk0##X=*(const u32x4*)(bk+ko); pv0##X=*(const u32x4*)(bv+ko); } \
      { int e=tid+512; pq1##X=*(const u32x4*)(bq+(size_t)(e>>4)*stride+(e&15)*16); int row=e>>3; size_t ko=(size_t)(row>>1)*stride+(row&1)*128+(e&7)*16; pk1##X=*(const u32x4*)(bk+ko); pv1##X=*(const u32x4*)(bv+ko); } \
      pt0##X=*(const u32x4*)(ta+tid*16); pt1##X=*(const u32x4*)(ta+8192+tid*16); pt2##X=*(const u32x4*)(ta+16384+tid*16); \
      pg##X = tid<64 ? *(const float*)(ta+24576+tid*4) : 0.f; }
#define FILL(X) { { int e=tid; *(u32x4*)(smem+SQ+(e>>4)*272+(e&15)*16)=pq0##X; int row=e>>3; *(u32x4*)(smem+SKT+row*144+(e&7)*16)=pk0##X; *(u32x4*)(smem+SVT+row*144+(e&7)*16)=pv0##X; } \
      { int e=tid+512; *(u32x4*)(smem+SQ+(e>>4)*272+(e&15)*16)=pq1##X; int row=e>>3; *(u32x4*)(smem+SKT+row*144+(e&7)*16)=pk1##X; *(u32x4*)(smem+SVT+row*144+(e&7)*16)=pv1##X; } \
      { int row=tid>>3, c16=tid&7; *(u32x4*)(smem+STW+row*144+c16*16)=pt0##X; *(u32x4*)(smem+STU+row*144+c16*16)=pt1##X; *(u32x4*)(smem+SAT+row*144+c16*16)=pt2##X; } \
      if (tid<64) *(float*)(smem+SGC+tid*4)=pg##X; }
    __syncthreads();
    PREFETCH(A,0); FILL(A);
    __syncthreads();
    for (int s2=0; s2<132; s2+=2){
      { const int s=s2;
        if (s+1<132) PREFETCH(A,s+1);
      f32x4 wacc[4], vn[4];
      _Pragma("unroll") for (int i=0;i<4;++i){ wacc[i]=f32x4{0.f,0.f,0.f,0.f}; vn[i]=f32x4{0.f,0.f,0.f,0.f}; }
      _Pragma("unroll") for (int ks=0;ks<2;++ks){ int kb=(ks*32+kg*8)*2;
        bf16x8 A=lds128(SKT+(wv*16+r)*144+kb);
        bf16x8 Bv=lds128(SVT+(wv*16+r)*144+kb);
        _Pragma("unroll") for (int t=0;t<4;++t){
          wacc[t]=MF(A, lds128(STW+(t*16+r)*144+kb), wacc[t]);
          vn[t]=MF(lds128(STU+(t*16+r)*144+kb), Bv, vn[t]); } }
      _Pragma("unroll") for (int t=0;t<4;++t){ uint2 pk2; pk2.x=pack2(-wacc[t][0],-wacc[t][1]); pk2.y=pack2(-wacc[t][2],-wacc[t][3]);
        *(uint2*)(smem+SWB+(t*16+r)*272+(wv*16+kg*4)*2)=pk2; }
      __syncthreads();
      bf16x8 Sf[4];
      _Pragma("unroll") for (int q=0;q<4;++q) Sf[q]=packfrag(Sacc[2*q],Sacc[2*q+1]);
      f32x4 oacc[4];
      _Pragma("unroll") for (int i=0;i<4;++i) oacc[i]=f32x4{0.f,0.f,0.f,0.f};
      _Pragma("unroll") for (int q=0;q<4;++q){ int kb=(32*q+kg*4)*2;
        _Pragma("unroll") for (int t=0;t<4;++t){
          vn[t]=MF(lds64x2(SWB+(t*16+r)*272+kb), Sf[q], vn[t]);
          oacc[t]=MF(lds64x2(SQ+(t*16+r)*272+kb), Sf[q], oacc[t]); } }
      const float* gcs=(const float*)(smem+SGC);
      float gl = d ? gcs[0] : gcs[63];
      float gam=__expf(gl);
      f32x4 vs[4];
      _Pragma("unroll") for (int t=0;t<4;++t){ float4 g4=*(const float4*)(gcs+t*16+kg*4);
        oacc[t][0]*=__expf(g4.x); oacc[t][1]*=__expf(g4.y); oacc[t][2]*=__expf(g4.z); oacc[t][3]*=__expf(g4.w);
        vs[t][0]=vn[t][0]*__expf(gl-g4.x); vs[t][1]=vn[t][1]*__expf(gl-g4.y); vs[t][2]=vn[t][2]*__expf(gl-g4.z); vs[t][3]=vn[t][3]*__expf(gl-g4.w); }
      bf16x8 Vf[2], Wf[2];
      _Pragma("unroll") for (int q=0;q<2;++q){ Vf[q]=packfrag(vn[2*q],vn[2*q+1]); Wf[q]=packfrag(vs[2*q],vs[2*q+1]); }
      _Pragma("unroll") for (int q=0;q<2;++q){ int kb=(32*q+kg*4)*2;
        _Pragma("unroll") for (int t=0;t<4;++t) oacc[t]=MF(lds64x2(SAT+(t*16+r)*144+kb), Vf[q], oacc[t]); }
      _Pragma("unroll") for (int m8=0;m8<8;++m8){ Sacc[m8][0]*=gam; Sacc[m8][1]*=gam; Sacc[m8][2]*=gam; Sacc[m8][3]*=gam; }
      _Pragma("unroll") for (int q=0;q<2;++q){ int kb=(32*q+kg*4)*2;
        _Pragma("unroll") for (int m8=0;m8<8;++m8) Sacc[m8]=MF(lds64x2(SKT+(m8*16+r)*144+kb), Wf[q], Sacc[m8]); }
      if (s>=4){ int cidx=4+(d?131-s:s-4); char* op=tabase+(size_t)((b*8+h)*132+cidx)*TA_STRIDE;
        _Pragma("unroll") for (int t=0;t<4;++t) _Pragma("unroll") for (int j=0;j<4;++j)
          *(u16*)(op+((t*16+kg*4+j)*128+wv*16+r)*2)=f2bf(oacc[t][j]); }
        __syncthreads();
        FILL(A);
        __syncthreads();
      }
      { const int s=s2+1;
        if (s+1<132) PREFETCH(A,s+1);
      f32x4 wacc[4], vn[4];
      _Pragma("unroll") for (int i=0;i<4;++i){ wacc[i]=f32x4{0.f,0.f,0.f,0.f}; vn[i]=f32x4{0.f,0.f,0.f,0.f}; }
      _Pragma("unroll") for (int ks=0;ks<2;++ks){ int kb=(ks*32+kg*8)*2;
        bf16x8 A=lds128(SKT+(wv*16+r)*144+kb);
        bf16x8 Bv=lds128(SVT+(wv*16+r)*144+kb);
        _Pragma("unroll") for (int t=0;t<4;++t){
          wacc[t]=MF(A, lds128(STW+(t*16+r)*144+kb), wacc[t]);
          vn[t]=MF(lds128(STU+(t*16+r)*144+kb), Bv, vn[t]); } }
      _Pragma("unroll") for (int t=0;t<4;++t){ uint2 pk2; pk2.x=pack2(-wacc[t][0],-wacc[t][1]); pk2.y=pack2(-wacc[t][2],-wacc[t][3]);
        *(uint2*)(smem+SWB+(t*16+r)*272+(wv*16+kg*4)*2)=pk2; }
      __syncthreads();
      bf16x8 Sf[4];
      _Pragma("unroll") for (int q=0;q<4;++q) Sf[q]=packfrag(Sacc[2*q],Sacc[2*q+1]);
      f32x4 oacc[4];
      _Pragma("unroll") for (int i=0;i<4;++i) oacc[i]=f32x4{0.f,0.f,0.f,0.f};
      _Pragma("unroll") for (int q=0;q<4;++q){ int kb=(32*q+kg*4)*2;
        _Pragma("unroll") for (int t=0;t<4;++t){
          vn[t]=MF(lds64x2(SWB+(t*16+r)*272+kb), Sf[q], vn[t]);
          oacc[t]=MF(lds64x2(SQ+(t*16+r)*272+kb), Sf[q], oacc[t]); } }
      const float* gcs=(const float*)(smem+SGC);
      float gl = d ? gcs[0] : gcs[63];
      float gam=__expf(gl);
      f32x4 vs[4];
      _Pragma("unroll") for (int t=0;t<4;++t){ float4 g4=*(const float4*)(gcs+t*16+kg*4);
        oacc[t][0]*=__expf(g4.x); oacc[t][1]*=__expf(g4.y); oacc[t][2]*=__expf(g4.z); oacc[t][3]*=__expf(g4.w);
        vs[t][0]=vn[t][0]*__expf(gl-g4.x); vs[t][1]=vn[t][1]*__expf(gl-g4.y); vs[t][2]=vn[t][2]*__expf(gl-g4.z); vs[t][3]=vn[t][3]*__expf(gl-g4.w); }
      bf16x8 Vf[2], Wf[2];
      _Pragma("unroll") for (int q=0;q<2;++q){ Vf[q]=packfrag(vn[2*q],vn[2*q+1]); Wf[q]=packfrag(vs[2*q],vs[2*q+1]); }
      _Pragma("unroll") for (int q=0;q<2;++q){ int kb=(32*q+kg*4)*2;
        _Pragma("unroll") for (int t=0;t<4;++t) oacc[t]=MF(lds64x2(SAT+(t*16+r)*144+kb), Vf[q], oacc[t]); }
      _Pragma("unroll") for (int m8=0;m8<8;++m8){ Sacc[m8][0]*=gam; Sacc[m8][1]*=gam; Sacc[m8][2]*=gam; Sacc[m8][3]*=gam; }
      _Pragma("unroll") for (int q=0;q<2;++q){ int kb=(32*q+kg*4)*2;
        _Pragma("unroll") for (int m8=0;m8<8;++m8) Sacc[m8]=MF(lds64x2(SKT+(m8*16+r)*144+kb), Wf[q], Sacc[m8]); }
      if (s>=4){ int cidx=4+(d?131-s:s-4); char* op=tabase+(size_t)((b*8+h)*132+cidx)*TA_STRIDE;
        _Pragma("unroll") for (int t=0;t<4;++t) _Pragma("unroll") for (int j=0;j<4;++j)
          *(u16*)(op+((t*16+kg*4+j)*128+wv*16+r)*2)=f2bf(oacc[t][j]); }
        __syncthreads();
        if (s+1<132) FILL(A);
        __syncthreads();
      }
    }
  }
}

__device__ __forceinline__ void phase_oa(KP kp_){ asm volatile("" : "+s"(kp_)); const Params p=load_params(kp_);
  int ftid=threadIdx.x; asm volatile("" : "+v"(ftid));
  int lane=ftid&63, wid=ftid>>6;
  const char* taf=(const char*)p.out; const char* tab=(const char*)(p.ws+OFF_TAB);
  u16* ZA=(u16*)(p.ws+OFF_ZA);
  float g0=p.dn_norm_g[lane*2], g1=p.dn_norm_g[lane*2+1];
  for (int it=blockIdx.x*8+wid; it<16384*8; it+=gridDim.x*8){
    int tok=it>>3, h=it&7; int b=tok>>13, n=(tok>>6)&127, tl=tok&63;
    size_t ia=(size_t)((b*8+h)*132+4+n)*TA_STRIDE + (size_t)(tl*128+lane*2)*2;
    unsigned a=*(const unsigned*)(taf+ia), bb=*(const unsigned*)(tab+ia);
    size_t off=(size_t)it*128+lane*2;
    unsigned z=*(const unsigned*)(ZA+off);
    float o0=bf2f((u16)(a&0xffff))+bf2f((u16)(bb&0xffff)), o1=bf2f((u16)(a>>16))+bf2f((u16)(bb>>16));
    float ss=wave_sum(o0*o0+o1*o1); float r=rsqrtf(ss*(1.f/128.f)+EPSV);
    float r0=o0*r*g0*bf2f((u16)(z&0xffff)), r1=o1*r*g1*bf2f((u16)(z>>16));
    *(unsigned*)(ZA+off)=pack2(r0,r1);
  }
}

__device__ __forceinline__ void phase_merge(KP kp_){ asm volatile("" : "+s"(kp_)); const Params p=load_params(kp_);
  const u16* oa=(const u16*)(p.ws+OFF_OA); const u16* yb=(const u16*)(p.ws+OFF_YB);
  const u16* wpa=(const u16*)(p.ws+OFF_WTPA); const u16* wpb=(const u16*)(p.ws+OFF_WTPB);
  const u16* PG=(const u16*)p.out; float* MA=(float*)(p.ws+OFF_MA); u16* M=(u16*)(p.ws+OFF_M);
  for (int it=blockIdx.x; it<256; it+=gridDim.x){
    int ct=it&3, rt=it>>2;
    f32x4 acc[2][2][4][2];
    gemm_core(wpa, oa, ct*256, rt*256, acc);
    EPIG_BEGIN
      uint2 g[8];
      EPIG_FOR g[idx]=*(const uint2*)(PG+(size_t)(rt*256+C0)*2048+ct*256+R0); EPIG_ENDFOR
      EPIG_FOR f32x4 v=acc[ai][bj][m][n]; uint2 gg=g[idx];
        float4 r; r.x=v[0]*bf2f((u16)(gg.x&0xffff)); r.y=v[1]*bf2f((u16)(gg.x>>16)); r.z=v[2]*bf2f((u16)(gg.y&0xffff)); r.w=v[3]*bf2f((u16)(gg.y>>16));
        *(float4*)(MA+(size_t)(rt*256+C0)*1024+ct*256+R0)=r; EPIG_ENDFOR
    EPIG_END
  }
  for (int it=blockIdx.x; it<256; it+=gridDim.x){
    int ct=it&3, rt=it>>2;
    f32x4 acc[2][2][4][2];
    gemm_core(wpb, yb, ct*256, rt*256, acc);
    EPIG_BEGIN
      uint2 g[8]; float4 ra[8];
      EPIG_FOR g[idx]=*(const uint2*)(PG+(size_t)(rt*256+C0)*2048+1024+ct*256+R0); ra[idx]=*(const float4*)(MA+(size_t)(rt*256+C0)*1024+ct*256+R0); EPIG_ENDFOR
      EPIG_FOR f32x4 v=acc[ai][bj][m][n]; uint2 gg=g[idx]; float4 r=ra[idx];
        r.x+=v[0]*bf2f((u16)(gg.x&0xffff)); r.y+=v[1]*bf2f((u16)(gg.x>>16)); r.z+=v[2]*bf2f((u16)(gg.y&0xffff)); r.w+=v[3]*bf2f((u16)(gg.y>>16));
        uint2 pk; pk.x=pack2(r.x,r.y); pk.y=pack2(r.z,r.w);
        *(uint2*)(M+(size_t)(rt*256+C0)*1024+ct*256+R0)=pk; EPIG_ENDFOR
    EPIG_END
  }
}
__device__ __forceinline__ void phase_out(KP kp_){ asm volatile("" : "+s"(kp_)); const Params p=load_params(kp_);
  const u16* M=(const u16*)(p.ws+OFF_M); const u16* wo=(const u16*)(p.ws+OFF_WTOUT);
  const float* modv=(const float*)(p.ws+OFF_MOD);
  for (int it=blockIdx.x; it<256; it+=gridDim.x){
    int ct=it&3, rt=it>>2;
    f32x4 acc[2][2][4][2];
    gemm_core(wo, M, ct*256, rt*256, acc);
    EPIG_BEGIN
      float4 xa[8], ga[8];
      EPIG_FOR int tok=rt*256+C0; xa[idx]=*(const float4*)(p.x+(size_t)tok*1024+ct*256+R0); ga[idx]=*(const float4*)(modv+(tok>>13)*3072+2048+ct*256+R0); EPIG_ENDFOR
      EPIG_FOR f32x4 v=acc[ai][bj][m][n]; float4 xv=xa[idx], gt=ga[idx];
        float4 r; r.x=xv.x+gt.x*v[0]; r.y=xv.y+gt.y*v[1]; r.z=xv.z+gt.z*v[2]; r.w=xv.w+gt.w*v[3];
        *(float4*)(p.out+(size_t)(rt*256+C0)*1024+ct*256+R0)=r; EPIG_ENDFOR
    EPIG_END
  }
}

__device__ __forceinline__ void phase_final(KP kp_){ asm volatile("" : "+s"(kp_)); const Params p=load_params(kp_);
  int ftid=threadIdx.x; asm volatile("" : "+v"(ftid));
  int lane=ftid&63, wid=ftid>>6;
  for (int r=blockIdx.x*8+wid; r<16384; r+=gridDim.x*8){
    float4 xv[4]; float ss=0.f;
    for(int i=0;i<4;++i){ xv[i]=*(const float4*)(p.out+(size_t)r*1024+lane*4+256*i); ss+=xv[i].x*xv[i].x+xv[i].y*xv[i].y+xv[i].z*xv[i].z+xv[i].w*xv[i].w; }
    ss=wave_sum(ss); float rstd=rsqrtf(ss*(1.f/1024.f)+EPSV);
    for(int i=0;i<4;++i){ int col=lane*4+256*i; float4 v=xv[i]; float4 g=*(const float4*)(p.final_g+col);
      v.x*=rstd*g.x; v.y*=rstd*g.y; v.z*=rstd*g.z; v.w*=rstd*g.w; *(float4*)(p.out+(size_t)r*1024+col)=v; }
  }
}

#define XB_TMO      128
#define XB_XCNT(j)  (256  + 64 * (j))
#define XB_XSUB(j)  (1280 + 64 * (j))
#define XB_XGEN(j)  (2304 + 64 * (j))
#define XB_TOP      3328
#define XB_TOPGEN   3392
#define XCD_BAR_WORDS 3456
#define XB_SPIN_CAP (1u << 18)
#define LAS __attribute__((address_space(3)))

__device__ __forceinline__ unsigned xb_ld(unsigned* p)              { return __hip_atomic_load(p, __ATOMIC_RELAXED, __HIP_MEMORY_SCOPE_AGENT); }
__device__ __forceinline__ unsigned xb_add(unsigned* p, unsigned v) { return __hip_atomic_fetch_add(p, v, __ATOMIC_RELAXED, __HIP_MEMORY_SCOPE_AGENT); }
__device__ __forceinline__ unsigned xb_xcc_id() { return (unsigned)__builtin_amdgcn_s_getreg((3 << 11) | 20) & 0xFu; }
#define XB_SPIN(cond, bar) do { unsigned _sp = 0; while (cond) { __builtin_amdgcn_s_sleep(1); \
    if ((++_sp & 255u) == 0u) { if (xb_ld(&(bar)[XB_TMO])) break; if (_sp > XB_SPIN_CAP) { atomicAdd(&(bar)[XB_TMO], 1u); break; } } } } while (0)

struct XcdBarrier {
    unsigned* bar; unsigned x;
    volatile LAS unsigned* st;
};

__device__ __forceinline__ XcdBarrier xcd_barrier_post(unsigned* bar, volatile LAS unsigned* st) {
    XcdBarrier b; b.bar = bar; b.x = xb_xcc_id(); b.st = st;
    if (threadIdx.x == 0) (void)xb_add(&bar[XB_XCNT(b.x)], 1u);
    return b;
}
__device__ __forceinline__ void xcd_barrier_complete(unsigned* bar, unsigned x, unsigned& nloc, unsigned& nx) {
    const unsigned G = gridDim.x * gridDim.y * gridDim.z;
    unsigned sum, cnt, mine, sp = 0u;
    for (;;) {
        sum = 0u; cnt = 0u; mine = 0u;
#pragma unroll
        for (unsigned j = 0; j < 16; ++j) { const unsigned c = xb_ld(&bar[XB_XCNT(j)]); sum += c; cnt += (c > 0u) ? 1u : 0u; mine = (j == x) ? c : mine; }
        if (sum == G) break;
        __builtin_amdgcn_s_sleep(1);
        if ((++sp & 255u) == 0u) { if (xb_ld(&bar[XB_TMO])) break; if (sp > XB_SPIN_CAP) { atomicAdd(&bar[XB_TMO], 1u); break; } }
    }
    nloc = mine > 0u ? mine : 1u; nx = cnt > 0u ? cnt : 1u;
}

__device__ __forceinline__ void xcd_barrier(const XcdBarrier& b) {
    asm volatile("s_waitcnt vmcnt(0)" ::: "memory");
    __syncthreads();
    if (threadIdx.x == 0) {
        unsigned* bar = b.bar;
        __builtin_amdgcn_s_waitcnt(0);
        unsigned nloc = b.st[0], nx = b.st[1];
        if (nloc == 0u) { xcd_barrier_complete(bar, b.x, nloc, nx); b.st[0] = nloc; b.st[1] = nx; }
        const unsigned old = xb_add(&bar[XB_XSUB(b.x)], 1u);
        const unsigned gen = old / nloc;
        if (old + 1u == (gen + 1u) * nloc) {
            __builtin_amdgcn_fence(__ATOMIC_RELEASE, "agent");
            asm volatile("s_waitcnt vmcnt(0)" ::: "memory");
            const unsigned og = xb_add(&bar[XB_TOP], 1u);
            const unsigned tg = og / nx;
            if (og + 1u == (tg + 1u) * nx) xb_add(&bar[XB_TOPGEN], 1u);
            else XB_SPIN(xb_ld(&bar[XB_TOPGEN]) == tg, bar);
            __builtin_amdgcn_fence(__ATOMIC_ACQUIRE, "agent");
            xb_add(&bar[XB_XGEN(b.x)], 1u);
            asm volatile("s_waitcnt vmcnt(0)" ::: "memory");
        } else {
            XB_SPIN(xb_ld(&bar[XB_XGEN(b.x)]) == gen, bar);
            __builtin_amdgcn_fence(__ATOMIC_ACQUIRE, "agent");
            asm volatile("s_waitcnt vmcnt(0)" ::: "memory");
        }
    }
    __syncthreads();
}


__global__ void __launch_bounds__(NTH) mega(Params p_arg){
  cg::grid_group grid = cg::this_grid();
  KP kp = (KP)__builtin_amdgcn_kernarg_segment_ptr();
  volatile LAS unsigned* xst=(volatile LAS unsigned*)((LAS char*)smem+(LDS_BYTES-16));
  if (threadIdx.x==0){ xst[0]=0u; xst[1]=0u; }
  __syncthreads();
  XcdBarrier xb;
  { unsigned long long wsp=kp[28]; xb=xcd_barrier_post((unsigned*)((char*)wsp+OFF_BAR), xst); }
  int rep_a, rep_b;
  { unsigned long long rr=kp[29]; rep_a=(int)(rr&0xffffffffull); rep_b=(int)(rr>>32); }
  for (int r_=0;r_<((rep_b>>8)&255);++r_){ phase_prep(kp);
    if (rep_a==0x7fffffff) grid.sync();
    xcd_barrier(xb); }
  phase_h(kp);        xcd_barrier(xb);
  for (int r_=0;r_<(rep_b&255);++r_){ phase_gemm_dn(kp);  xcd_barrier(xb); }
  phase_dnprep(kp);   xcd_barrier(xb);
  if (gridDim.x>64){ if (blockIdx.x<32) phase_scan(kp); else phase_side(kp,blockIdx.x-32,gridDim.x-32); }
  else { phase_scan(kp); phase_side(kp,blockIdx.x,gridDim.x); }
  xcd_barrier(xb);
  phase_oa(kp);       xcd_barrier(xb);
  for (int hf=0; hf<2; ++hf){
    phase_gemm_hy(kp,hf); xcd_barrier(xb);
    phase_hyena(kp,hf);   xcd_barrier(xb);
  }
  phase_ybt(kp);    xcd_barrier(xb);
  phase_merge(kp);  xcd_barrier(xb);
  phase_out(kp);    xcd_barrier(xb);
  phase_final(kp);
}

extern "C" void kernel_launch(void* const* d_in, const int* in_sizes, int n_in,
                              void* d_out, int out_size, void* d_ws, size_t ws_size,
                              hipStream_t stream) {
  static int grid_blocks = 0;
  if (!grid_blocks) {
    int dev=0, cus=0, per_cu=0;
    hipGetDevice(&dev);
    hipDeviceGetAttribute(&cus, hipDeviceAttributeMultiprocessorCount, dev);
    hipFuncSetAttribute((const void*)mega, hipFuncAttributeMaxDynamicSharedMemorySize, LDS_BYTES);
    hipOccupancyMaxActiveBlocksPerMultiprocessor(&per_cu, (const void*)mega, NTH, LDS_BYTES);
    if (per_cu < 1) per_cu = 1;
    grid_blocks = cus * per_cu;
    if (grid_blocks > 256) grid_blocks = 256;
  }
  if (ws_size < WS_NEED) { fprintf(stderr, "workspace too small: %zu < %zu\n", ws_size, (size_t)WS_NEED); return; }
  Params p{};
  const float** pp = (const float**)&p;
  for (int i=0;i<27;++i) pp[i]=(const float*)d_in[i];
  p.out=(float*)d_out; p.ws=(char*)d_ws; p.rep_a=REP_A; p.rep_b=REP_B;
  hipMemsetAsync((char*)d_ws+OFF_BAR, 0, 16384, stream);
  void* args[] = {&p};
  hipError_t e = hipLaunchCooperativeKernel((const void*)mega, dim3(grid_blocks), dim3(NTH), args, LDS_BYTES, stream);
  if (e != hipSuccess) fprintf(stderr, "cooperative launch failed: %s (grid %d)\n", hipGetErrorString(e), grid_blocks);
}
```
